# Optimizing an MI355X kernel written in HIP

```python
import math
import jax, jax.numpy as jnp
from jax import lax
import numpy as np

D_MODEL = 1024
BATCH = 8
SEQ = 2048
DEPTH = 2

EPS = 1e-6
CONV_CH = D_MODEL
CONV_K = 31
CONV_PAD = (CONV_K - 1) // 2
ATTN_HEADS = 8
ATTN_DH = 64
ATTN_QK = ATTN_HEADS * 2 * ATTN_DH
ATTN_V = ATTN_HEADS * 2 * ATTN_DH
Q_BLOCK = 128
SGU_WIDTH = D_MODEL
SGU_GROUPS = 8
SGU_GROUP_DIM = SGU_WIDTH // SGU_GROUPS
CHUNK = 128
N_BRANCH = 3
D_FF = 4 * D_MODEL
COL_SIZES = (CONV_CH, CONV_CH, ATTN_QK, ATTN_QK, ATTN_V, SGU_WIDTH, SGU_WIDTH, N_BRANCH * D_MODEL)
SPLITS = tuple(int(s) for s in np.cumsum(COL_SIZES)[:-1])
W_IN_COLS = int(sum(COL_SIZES))

kernel_name = "hybrid_conv_diffattn_sgu_encoder"


def rms_norm(x, g):
    xf = x.astype(jnp.float32)
    y = xf * lax.rsqrt(jnp.mean(xf * xf, axis=-1, keepdims=True) + EPS)
    return (y * g.astype(jnp.float32)).astype(x.dtype)


def layer_norm(x, g, b):
    xf = x.astype(jnp.float32)
    mu = jnp.mean(xf, axis=-1, keepdims=True)
    xc = xf - mu
    y = xc * lax.rsqrt(jnp.mean(xc * xc, axis=-1, keepdims=True) + EPS)
    return (y * g.astype(jnp.float32) + b.astype(jnp.float32)).astype(x.dtype)


def alibi_slopes(n_heads):
    return jnp.exp2(-8.0 * jnp.arange(1, n_heads + 1, dtype=jnp.float32) / n_heads)


def depthwise_conv(x, w, b):
    c = x.shape[-1]
    y = lax.conv_general_dilated(
        x, w[:, None, :].astype(x.dtype), window_strides=(1,),
        padding=[(CONV_PAD, CONV_PAD)],
        dimension_numbers=("NWC", "WIO", "NWC"), feature_group_count=c)
    return y + b.astype(x.dtype)


def diff_attention(q, k, v, lam, slopes):
    b, s = q.shape[0], q.shape[1]
    nb = s // Q_BLOCK
    scale = ATTN_DH ** -0.5
    pos = jnp.arange(s, dtype=jnp.float32)
    qb = q.reshape(b, nb, Q_BLOCK, ATTN_HEADS, 2, ATTN_DH).transpose(1, 0, 2, 3, 4, 5)
    qpos = pos.reshape(nb, Q_BLOCK)
    kf = k.astype(jnp.float32)
    vf = v.astype(jnp.float32)

    def block(args):
        qblk, tq = args
        sc = jnp.einsum("bqhjd,bkhjd->bhjqk", qblk.astype(jnp.float32), kf) * scale
        dist = jnp.abs(tq[:, None] - pos[None, :])
        sc = sc - slopes[None, :, None, None, None] * dist[None, None, None]
        p = jax.nn.softmax(sc, axis=-1)
        a = p[:, :, 0] - lam * p[:, :, 1]
        return jnp.einsum("bhqk,bkhe->bqhe", a, vf)

    o = lax.map(block, (qb, qpos))
    return o.transpose(1, 0, 2, 3, 4).reshape(b, s, ATTN_HEADS, 2 * ATTN_DH).astype(q.dtype)


def spatial_gating(u, v, w_s, b_s):
    b, s, _ = v.shape
    n = s // CHUNK
    vc = v.reshape(b, n, CHUNK, SGU_GROUPS, SGU_GROUP_DIM)
    mixed = jnp.einsum("gts,bnsgc->bntgc", w_s.astype(v.dtype), vc) + b_s.T.astype(v.dtype)[None, None, :, :, None]
    return u * mixed.reshape(b, s, SGU_WIDTH)


def setup_inputs(seed: int = 0) -> dict:
    key = jax.random.key(seed)
    ks = jax.random.split(key, 32)
    f32 = jnp.float32
    L, D = DEPTH, D_MODEL

    def nrm(k, shape, scale):
        return jax.random.normal(k, shape, f32) * scale

    def gain(k, shape):
        return 1.0 + 0.02 * jax.random.normal(k, shape, f32)

    return {
        "x": jax.random.normal(ks[0], (BATCH, SEQ, D), f32),
        "norm_mix_pre": gain(ks[1], (L, D)),
        "norm_mix_post": gain(ks[2], (L, D)),
        "w_in": nrm(ks[3], (L, D, W_IN_COLS), D ** -0.5),
        "b_gate": nrm(ks[4], (L, N_BRANCH * D), 0.02),
        "conv_w": nrm(ks[5], (L, CONV_K, CONV_CH), CONV_K ** -0.5),
        "conv_b": nrm(ks[6], (L, CONV_CH), 0.02),
        "conv_ln_g": gain(ks[7], (L, CONV_CH)),
        "conv_ln_b": nrm(ks[8], (L, CONV_CH), 0.02),
        "lam_q1": nrm(ks[9], (L, ATTN_DH), 0.1),
        "lam_k1": nrm(ks[10], (L, ATTN_DH), 0.1),
        "lam_q2": nrm(ks[11], (L, ATTN_DH), 0.1),
        "lam_k2": nrm(ks[12], (L, ATTN_DH), 0.1),
        "subln_g": gain(ks[13], (L, 2 * ATTN_DH)),
        "sgu_ln_g": gain(ks[14], (L, SGU_WIDTH)),
        "sgu_ln_b": nrm(ks[15], (L, SGU_WIDTH), 0.02),
        "sgu_w": nrm(ks[16], (L, SGU_GROUPS, CHUNK, CHUNK), CHUNK ** -0.5),
        "sgu_b": gain(ks[17], (L, SGU_GROUPS, CHUNK)),
        "w_proj_conv": nrm(ks[18], (L, CONV_CH, D), CONV_CH ** -0.5),
        "w_proj_attn": nrm(ks[19], (L, ATTN_V, D), ATTN_V ** -0.5),
        "w_proj_sgu": nrm(ks[20], (L, SGU_WIDTH, D), SGU_WIDTH ** -0.5),
        "w_out": nrm(ks[21], (L, D, D), D ** -0.5),
        "norm_ffn_pre": gain(ks[22], (L, D)),
        "norm_ffn_post": gain(ks[23], (L, D)),
        "w_ffn_up": nrm(ks[24], (L, D, D_FF), D ** -0.5),
        "w_ffn_down": nrm(ks[25], (L, D_FF, D), D_FF ** -0.5),
    }


def reference(x, norm_mix_pre, norm_mix_post, w_in, b_gate, conv_w, conv_b, conv_ln_g, conv_ln_b,
              lam_q1, lam_k1, lam_q2, lam_k2, subln_g, sgu_ln_g, sgu_ln_b, sgu_w, sgu_b,
              w_proj_conv, w_proj_attn, w_proj_sgu, w_out, norm_ffn_pre, norm_ffn_post,
              w_ffn_up, w_ffn_down):
    b, s, _ = x.shape
    slopes = alibi_slopes(ATTN_HEADS)
    for l in range(DEPTH):
        h = rms_norm(x, norm_mix_pre[l])
        z = h @ w_in[l]
        za, zb, q, k, v, su, sv, gl = jnp.split(z, SPLITS, axis=-1)

        a = za * jax.nn.sigmoid(zb)
        a = depthwise_conv(a, conv_w[l], conv_b[l])
        a = jax.nn.silu(layer_norm(a, conv_ln_g[l], conv_ln_b[l]))
        y_a = a @ w_proj_conv[l]

        lam_init = 0.8 - 0.6 * math.exp(-0.3 * l)
        lam = (jnp.exp(jnp.sum(lam_q1[l].astype(jnp.float32) * lam_k1[l].astype(jnp.float32)))
               - jnp.exp(jnp.sum(lam_q2[l].astype(jnp.float32) * lam_k2[l].astype(jnp.float32)))
               + lam_init)
        o = diff_attention(q.reshape(b, s, ATTN_HEADS, 2, ATTN_DH),
                           k.reshape(b, s, ATTN_HEADS, 2, ATTN_DH),
                           v.reshape(b, s, ATTN_HEADS, 2 * ATTN_DH), lam, slopes)
        o = rms_norm(o, subln_g[l]) * (1.0 - lam_init)
        y_b = o.reshape(b, s, ATTN_V) @ w_proj_attn[l]

        gu = jax.nn.gelu(su, approximate=False)
        gv = layer_norm(jax.nn.gelu(sv, approximate=False), sgu_ln_g[l], sgu_ln_b[l])
        y_c = spatial_gating(gu, gv, sgu_w[l], sgu_b[l]) @ w_proj_sgu[l]

        g_a, g_b, g_c = jnp.split(jax.nn.sigmoid(gl + b_gate[l]), N_BRANCH, axis=-1)
        mix = (g_a * y_a + g_b * y_b + g_c * y_c) @ w_out[l]
        x = x + rms_norm(mix, norm_mix_post[l])

        h = rms_norm(x, norm_ffn_pre[l])
        f = jnp.square(jax.nn.relu(h @ w_ffn_up[l])) @ w_ffn_down[l]
        x = x + rms_norm(f, norm_ffn_post[l])
    return x
```

```cpp
#include <hip/hip_runtime.h>
#include <hip/hip_cooperative_groups.h>
#include <cstdio>
#include <cstdint>
namespace cg = cooperative_groups;

#ifndef MK_N_LAUNCHES
#define MK_N_LAUNCHES 1
#endif

#define LAS __attribute__((address_space(3)))
typedef unsigned short bf16_t;
typedef short bf16x8 __attribute__((ext_vector_type(8)));
typedef float f32x4 __attribute__((ext_vector_type(4)));
typedef float f32x2 __attribute__((ext_vector_type(2)));
typedef float f32x16 __attribute__((ext_vector_type(16)));
typedef unsigned u32x4 __attribute__((ext_vector_type(4)));
typedef unsigned u32x2 __attribute__((ext_vector_type(2)));

constexpr int DM = 1024, NB = 8, SEQ = 2048, DEPTH = 2, T = NB * SEQ, DFF = 4096, WIN = 10240;
constexpr float EPS = 1e-6f, LOG2E = 1.4426950408889634f;
constexpr int NTHREADS = 512, NWAVES = 8;

constexpr size_t MiB = 1u << 20;
constexpr size_t WS_W = 1 * MiB;
constexpr size_t WS_XN = 45 * MiB;
constexpr size_t WS_CA = 77 * MiB;
constexpr size_t WS_AG = 109 * MiB;
constexpr size_t WS_K = 141 * MiB;
constexpr size_t WS_VT = 173 * MiB;
constexpr size_t WS_GEL = 205 * MiB;
constexpr size_t WS_Q = 237 * MiB;
constexpr size_t WS_GU = 269 * MiB;
constexpr size_t WS_STAT = 301 * MiB;
constexpr size_t WS_XBUF = 303 * MiB;
constexpr size_t WS_END = 305 * MiB;
constexpr size_t WS_CNT = 16384;
constexpr size_t CTL_BYTES = 16384 + 8 * 64 * 256;
constexpr size_t WS_GS = WS_AG, WS_SB = WS_K, WS_MIXPRE = WS_GEL;
constexpr size_t WS_MIX = WS_AG;
constexpr size_t WS_H = WS_VT;
constexpr size_t WO_IN = 0, WO_PC = (size_t)WIN * DM, WO_PA = WO_PC + (size_t)DM * DM, WO_PS = WO_PA + (size_t)DM * DM,
                 WO_OUT = WO_PS + (size_t)DM * DM, WO_UP = WO_OUT + (size_t)DM * DM, WO_DOWN = WO_UP + (size_t)DFF * DM;

typedef __bf16 bf16x2_t __attribute__((ext_vector_type(2)));
__device__ __forceinline__ unsigned cvt_pk_bf16(float lo, float hi) { const f32x2 v = {lo, hi}; const bf16x2_t b = __builtin_convertvector(v, bf16x2_t); return __builtin_bit_cast(unsigned, b); }
__device__ __forceinline__ float bf_lo(unsigned u) { return __uint_as_float(u << 16); }
__device__ __forceinline__ float bf_hi(unsigned u) { return __uint_as_float(u & 0xffff0000u); }
__device__ __forceinline__ float fast_sigmoid(float x) { return __builtin_amdgcn_rcpf(1.0f + __builtin_amdgcn_exp2f(-x * LOG2E)); }
__device__ __forceinline__ int lane_id() { return (int)__builtin_amdgcn_mbcnt_hi(~0u, __builtin_amdgcn_mbcnt_lo(~0u, 0u)); }
__device__ __forceinline__ int lane_op() { unsigned z = 0u; asm volatile("" : "+v"(z)); return (int)__builtin_amdgcn_mbcnt_hi(~0u, __builtin_amdgcn_mbcnt_lo(~0u, z)); }
__device__ __forceinline__ float wave_sum(float v) {
    int lid = lane_id(); asm volatile("" : "+v"(lid));
#pragma unroll
    for (int o = 1; o < 64; o <<= 1) v += __int_as_float(__builtin_amdgcn_ds_bpermute((lid ^ o) << 2, __float_as_int(v)));
    return v;
}
__device__ __forceinline__ float swap_add(float v) { auto rr = __builtin_amdgcn_permlane32_swap(__float_as_uint(v), __float_as_uint(v), false, false); return __uint_as_float(rr[0]) + __uint_as_float(rr[1]); }
__device__ __forceinline__ float swap_max(float v) { auto rr = __builtin_amdgcn_permlane32_swap(__float_as_uint(v), __float_as_uint(v), false, false); return fmaxf(__uint_as_float(rr[0]), __uint_as_float(rr[1])); }
__device__ __forceinline__ f32x2 gelu_pk(f32x2 v) {
    const f32x2 av = __builtin_elementwise_abs(v), d = av * 0.2316418882f + 1.0f;
    f32x2 t; t.x = __builtin_amdgcn_rcpf(d.x); t.y = __builtin_amdgcn_rcpf(d.y);
    f32x2 q = t * 0.5307027145f + (-0.7265760135f); q = q * t + 0.7107068705f; q = q * t + (-0.142248368f); q = q * t + 0.127414796f; q = q * t;
    const f32x2 s = (v * v) * (-0.72134752044f);
    f32x2 e; e.x = __builtin_amdgcn_exp2f(s.x); e.y = __builtin_amdgcn_exp2f(s.y);
    const f32x2 m = v * (q * e), r = v - m;
    f32x2 o; o.x = v.x < 0.f ? m.x : r.x; o.y = v.y < 0.f ? m.y : r.y; return o;
}
__device__ __forceinline__ f32x4 gelu4(f32x4 v) { f32x2 a = gelu_pk((f32x2){v[0], v[1]}), b = gelu_pk((f32x2){v[2], v[3]}); return (f32x4){a.x, a.y, b.x, b.y}; }

namespace pg8 {
constexpr int BM = 256, BK = 64, HALF = 128, HTB = HALF * BK * 2, STAGE_BYTES = 8 * HTB, NXCD = 8, WGM = 8;
__host__ __device__ __forceinline__ int lds_byte(int r, int c) { const int st = (r >> 4) * 2 + (c >> 5), rr = r & 15, cc = c & 31, ob = rr * 64 + cc * 2; return st * 1024 + (ob ^ (((ob >> 9) & 1) << 5)); }
__host__ __device__ __forceinline__ void stage_rc(int b, int& R, int& C) { const int st = b / 1024, sb = b % 1024, swz = sb ^ (((sb >> 9) & 1) << 5); R = (st >> 1) * 16 + swz / 64; C = (st & 1) * 32 + (swz % 64) / 2; }
__host__ __device__ __forceinline__ int perm32(int rho) { const int n = rho >> 4, i = rho & 15; return 8 * (i >> 2) + 4 * n + (i & 3); }

struct Unit { int pm, pn, j; };
__device__ __forceinline__ void tile_map(int wgid, int nM, int nN, int& pm, int& pn) {
    const int nwg = nM * nN;
    { const int q = nwg / NXCD, r = nwg % NXCD, xcd = wgid % NXCD, off = wgid / NXCD; wgid = (xcd < r ? xcd * (q + 1) : r * (q + 1) + (xcd - r) * q) + off; }
    const int nig = WGM * nN, gid = wgid / nig, fm = gid * WGM, gsz = (nM - fm) < WGM ? (nM - fm) : WGM;
    pm = fm + ((wgid % nig) % gsz); pn = (wgid % nig) / gsz;
}

template <class Epi, class Sched, bool ALIGN_EPI = true>
__device__ __forceinline__ void gemm_phase(LAS unsigned char* lds, const int wave_s, const int K, const Sched& S, const Epi& E) {
    const int tid_ = wave_s * 64 + lane_op();
    const int tid = tid_, wid = wave_s, lane = tid & 63, wr = wid >> 2, wc = wid & 3, fr = lane & 15, fq = lane >> 4;
    const int nt = K / BK;
    unsigned voffA[2], voffB[2];
#pragma unroll
    for (int i = 0; i < 2; ++i) { int R, C; stage_rc(tid * 16 + i * 8192, R, C); const int Rb = (R & ~31) + perm32(R & 31);
        voffA[i] = (unsigned)(R * K + C) * 2u; voffB[i] = (unsigned)(Rb * K + C) * 2u; }
    const size_t kstep = (size_t)(BK * 2);
    const size_t hstep = (size_t)HALF * K * 2;
    const unsigned ldsw = (unsigned)wid * 1024u;
    const int aoff = lds_byte(wr * 64 + fr, fq * 8), boff = lds_byte(wc * 32 + fr, fq * 8);
#define PG8_SA(b, h) (((b) * 2 + (h)) * HTB)
#define PG8_SB(b, h) ((4 + (b) * 2 + (h)) * HTB)
#define PG8_STAGE(bufoff, gbase, voff) do { _Pragma("unroll") for (int _i = 0; _i < 2; ++_i) \
        __builtin_amdgcn_global_load_lds((const unsigned*)((const char*)(gbase) + (voff)[_i]), (LAS unsigned*)(lds + (bufoff) + ldsw + _i * 8192), 16, 0, 0); } while (0)
#define PG8_LDA(dst, b, h) do { _Pragma("unroll") for (int m = 0; m < 4; ++m) _Pragma("unroll") for (int k = 0; k < 2; ++k) dst[m][k] = *(const LAS bf16x8*)(lds + PG8_SA(b, h) + aoff + m * 2048 + k * 1024); } while (0)
#define PG8_LDB(dst, b, h) do { _Pragma("unroll") for (int n = 0; n < 2; ++n) _Pragma("unroll") for (int k = 0; k < 2; ++k) dst[n][k] = *(const LAS bf16x8*)(lds + PG8_SB(b, h) + boff + n * 2048 + k * 1024); } while (0)
#define PG8_MMA(ai, bj, At, Bt) do { __builtin_amdgcn_s_setprio(1); _Pragma("unroll") for (int m = 0; m < 4; ++m) _Pragma("unroll") for (int n = 0; n < 2; ++n) _Pragma("unroll") for (int k = 0; k < 2; ++k) \
        acc[ai][bj][m][n] = __builtin_amdgcn_mfma_f32_16x16x32_bf16(Bt[n][k], At[m][k], acc[ai][bj][m][n], 0, 0, 0); __builtin_amdgcn_s_setprio(0); } while (0)
#define PG8_WAIT_V(n) asm volatile("s_waitcnt vmcnt(" #n ")" ::: "memory")
#define PG8_WAIT_L(n) asm volatile("s_waitcnt lgkmcnt(" #n ")" ::: "memory")
#define PG8_BAR __builtin_amdgcn_s_barrier()
#define PG8_SCHED __builtin_amdgcn_sched_barrier(0)
    Unit cur, nxt; int ui = 0;
    if (!S.next(0, cur)) return;
    f32x4 acc[2][2][4][2];
#pragma unroll
    for (int a = 0; a < 2; ++a)
#pragma unroll
        for (int b = 0; b < 2; ++b)
#pragma unroll
            for (int m = 0; m < 4; ++m)
#pragma unroll
                for (int n = 0; n < 2; ++n) acc[a][b][m][n] = (f32x4){0.f, 0.f, 0.f, 0.f};
    bf16x8 At[4][2], B0[2][2], B1[2][2];
    const char* cA = S.aptr(cur); const char* cB = S.bptr(cur);
    PG8_STAGE(PG8_SB(0, 0), cB, voffB); PG8_STAGE(PG8_SB(0, 1), cB + hstep, voffB); PG8_STAGE(PG8_SA(0, 0), cA, voffA); PG8_STAGE(PG8_SA(0, 1), cA + hstep, voffA);
    if (wr == 1) PG8_BAR;
    PG8_WAIT_V(2); PG8_BAR;
    PG8_STAGE(PG8_SB(1, 0), cB + kstep, voffB); PG8_STAGE(PG8_SA(1, 0), cA + kstep, voffA); PG8_STAGE(PG8_SB(1, 1), cB + hstep + kstep, voffB);
    PG8_WAIT_V(6); PG8_BAR;
    for (;;) {
        const bool has_next = S.next(ui + 1, nxt);
        const char* nA = has_next ? S.aptr(nxt) : cA; const char* nB = has_next ? S.bptr(nxt) : cB;
        for (int t = 0; t < nt; t += 2) {
            const bool last = (t == nt - 2);
            const char* a1 = cA + (size_t)(t + 1) * kstep;
            const char* a2 = last ? nA : cA + (size_t)(t + 2) * kstep; const char* b2 = last ? nB : cB + (size_t)(t + 2) * kstep;
            const char* a3 = a2 + kstep; const char* b3 = b2 + kstep;
            PG8_LDB(B0, 0, 0); PG8_LDB(B1, 0, 1); PG8_SCHED; PG8_LDA(At, 0, 0); PG8_STAGE(PG8_SA(1, 1), a1 + hstep, voffA);
            PG8_WAIT_V(8); PG8_WAIT_L(0); PG8_BAR; PG8_MMA(0, 0, At, B0); PG8_MMA(0, 1, At, B1); PG8_BAR; PG8_SCHED;
            PG8_LDA(At, 0, 1); PG8_STAGE(PG8_SB(0, 0), b2, voffB); PG8_STAGE(PG8_SB(0, 1), b2 + hstep, voffB); PG8_STAGE(PG8_SA(0, 0), a2, voffA);
            PG8_WAIT_V(8); PG8_WAIT_L(0); PG8_BAR; PG8_MMA(1, 0, At, B0); PG8_MMA(1, 1, At, B1); PG8_BAR; PG8_SCHED;
            PG8_LDB(B0, 1, 0); PG8_LDB(B1, 1, 1); PG8_SCHED; PG8_LDA(At, 1, 0); PG8_STAGE(PG8_SA(0, 1), a2 + hstep, voffA);
            PG8_WAIT_V(8); PG8_WAIT_L(0); PG8_BAR; PG8_MMA(0, 0, At, B0); PG8_MMA(0, 1, At, B1); PG8_BAR; PG8_SCHED;
            PG8_LDA(At, 1, 1); PG8_STAGE(PG8_SB(1, 0), b3, voffB); PG8_STAGE(PG8_SB(1, 1), b3 + hstep, voffB); PG8_STAGE(PG8_SA(1, 0), a3, voffA);
            PG8_WAIT_V(8); PG8_WAIT_L(0); PG8_BAR; PG8_MMA(1, 0, At, B0); PG8_MMA(1, 1, At, B1); PG8_BAR; PG8_SCHED;
        }
        if constexpr (ALIGN_EPI) { if (wr == 0) PG8_BAR; }
        E(acc, cur, wr, wc, fr, fq);
        if (!has_next) break;
#pragma unroll
        for (int a = 0; a < 2; ++a)
#pragma unroll
            for (int b = 0; b < 2; ++b)
#pragma unroll
                for (int m = 0; m < 4; ++m)
#pragma unroll
                    for (int n = 0; n < 2; ++n) acc[a][b][m][n] = (f32x4){0.f, 0.f, 0.f, 0.f};
        cur = nxt; cA = nA; cB = nB; ++ui;
        if constexpr (ALIGN_EPI) { if (wr == 1) PG8_BAR; }
    }
    PG8_WAIT_V(0);
    if constexpr (!ALIGN_EPI) { if (wr == 0) PG8_BAR; }
    PG8_BAR;
#undef PG8_SA
#undef PG8_SB
#undef PG8_STAGE
#undef PG8_LDA
#undef PG8_LDB
#undef PG8_MMA
#undef PG8_WAIT_V
#undef PG8_WAIT_L
#undef PG8_BAR
#undef PG8_SCHED
}
}
using pg8::Unit;

struct SchedSimple {
    const bf16_t* A; const bf16_t* Bt; int nM, nN, K, G, c;
    __device__ __forceinline__ bool next(int i, Unit& u) const { const long L = (long)i * G + c; if (L >= (long)nM * nN) return false; pg8::tile_map((int)L, nM, nN, u.pm, u.pn); u.j = 0; return true; }
    __device__ __forceinline__ const char* aptr(const Unit& u) const { return (const char*)A + (size_t)u.pm * 256 * K * 2; }
    __device__ __forceinline__ const char* bptr(const Unit& u) const { return (const char*)Bt + (size_t)u.pn * 256 * K * 2; }
};
struct SchedIn {
    const bf16_t* XN; const bf16_t* W; int G, c;
    __device__ __forceinline__ bool next(int i, Unit& u) const {
        const int L = i * G + c;
        if (L < 64 * 24) { pg8::tile_map(L, 64, 24, u.pm, u.pn); u.j = 0; return true; }
        const int L1 = L - 64 * 24; if (L1 >= 4 * 64) return false;
        pg8::tile_map(L1, 4, 64, u.pm, u.pn); u.j = 1; return true;
    }
    __device__ __forceinline__ const char* aptr(const Unit& u) const { return u.j == 0 ? (const char*)XN + (size_t)u.pm * 256 * DM * 2 : (const char*)W + (size_t)(6144 + u.pm * 256) * DM * 2; }
    __device__ __forceinline__ const char* bptr(const Unit& u) const { return u.j == 0 ? (const char*)W + (size_t)u.pn * 256 * DM * 2 : (const char*)XN + (size_t)u.pn * 256 * DM * 2; }
};
struct SchedProj {
    const unsigned char* ws; int G, c;
    __device__ __forceinline__ bool next(int i, Unit& u) const { const int L = (i / 6) * G + c; if (L >= 256) return false; pg8::tile_map(L, 64, 4, u.pm, u.pn); u.j = i % 6; return true; }
    __device__ __forceinline__ const char* aptr(const Unit& u) const { const int br = u.j >> 1;
        const size_t off = (u.j & 1) ? (br == 0 ? WS_CA : br == 1 ? WS_Q : WS_GU) : WS_XN; return (const char*)ws + off + (size_t)u.pm * 256 * DM * 2; }
    __device__ __forceinline__ const char* bptr(const Unit& u) const { const int br = u.j >> 1;
        const size_t off = (u.j & 1) ? (WS_W + 2 * (WO_PC + (size_t)br * DM * DM)) : (WS_W + 2 * (WO_IN + (size_t)(7168 + br * 1024) * DM)); return (const char*)ws + off + (size_t)u.pn * 256 * DM * 2; }
};

constexpr float QSCALE = 0.125f * LOG2E;
struct EpiIn {
    bf16_t *AG, *Q, *Kb, *GU, *GEL, *VT; float* STAT;
    __device__ __forceinline__ void operator()(const f32x4 (&acc)[2][2][4][2], const Unit& u, int wr, int wc, int fr, int fq) const {
        const int row0 = u.pm * 256 + wr * 64 + fr;
        if (u.j == 1) {
#pragma unroll
            for (int ai = 0; ai < 2; ++ai)
#pragma unroll
                for (int m = 0; m < 4; ++m) { bf16_t* rowp = VT + (size_t)(row0 + ai * 128 + m * 16) * T + u.pn * 256 + wc * 32 + 16 * (fq >> 1);
#pragma unroll
                    for (int bj = 0; bj < 2; ++bj)
#pragma unroll
                        for (int n = 0; n < 2; ++n) { const f32x4 v = acc[ai][bj][m][n]; u32x2 w; w.x = cvt_pk_bf16(v[0], v[1]); w.y = cvt_pk_bf16(v[2], v[3]);
                            *(u32x2*)(rowp + bj * 128 + 4 * (2 * n + (fq & 1))) = w; } }
            return;
        }
        const int pn = u.pn;
        if (pn < 8) {
            const int col = pn * 128 + wc * 32 + 8 * fq;
#pragma unroll
            for (int ai = 0; ai < 2; ++ai)
#pragma unroll
                for (int m = 0; m < 4; ++m) { f32x4 v0 = acc[ai][0][m][0], v1 = acc[ai][0][m][1]; const f32x4 g0 = acc[ai][1][m][0], g1 = acc[ai][1][m][1];
#pragma unroll
                    for (int i = 0; i < 4; ++i) { v0[i] *= fast_sigmoid(g0[i]); v1[i] *= fast_sigmoid(g1[i]); }
                    u32x4 w; w.x = cvt_pk_bf16(v0[0], v0[1]); w.y = cvt_pk_bf16(v0[2], v0[3]); w.z = cvt_pk_bf16(v1[0], v1[1]); w.w = cvt_pk_bf16(v1[2], v1[3]);
                    *(u32x4*)(AG + (size_t)(row0 + ai * 128 + m * 16) * DM + col) = w; }
            return;
        }
        const int sec = (pn - 8) >> 2;
        bf16_t* base = sec == 0 ? Q : sec == 1 ? Kb : sec == 2 ? GU : GEL;
        const int col = ((pn - 8) & 3) * 256 + wc * 32 + 8 * fq;
        const float sc = sec == 0 ? QSCALE : 1.0f;
#pragma unroll
        for (int ai = 0; ai < 2; ++ai)
#pragma unroll
            for (int m = 0; m < 4; ++m) { bf16_t* rowp = base + (size_t)(row0 + ai * 128 + m * 16) * DM + col; float ps = 0.f, ps2 = 0.f;
#pragma unroll
                for (int bj = 0; bj < 2; ++bj) { f32x4 v0 = acc[ai][bj][m][0], v1 = acc[ai][bj][m][1];
                    if (sec >= 2) { v0 = gelu4(v0); v1 = gelu4(v1); }
                    v0 = v0 * sc; v1 = v1 * sc;
                    if (sec == 3) { ps += (v0[0] + v0[1]) + (v0[2] + v0[3]) + (v1[0] + v1[1]) + (v1[2] + v1[3]);
                        ps2 += (v0[0] * v0[0] + v0[1] * v0[1]) + (v0[2] * v0[2] + v0[3] * v0[3]) + (v1[0] * v1[0] + v1[1] * v1[1]) + (v1[2] * v1[2] + v1[3] * v1[3]); }
                    u32x4 w; w.x = cvt_pk_bf16(v0[0], v0[1]); w.y = cvt_pk_bf16(v0[2], v0[3]); w.z = cvt_pk_bf16(v1[0], v1[1]); w.w = cvt_pk_bf16(v1[2], v1[3]);
                    *(u32x4*)(rowp + bj * 128) = w; }
                if (sec == 3) {
                    const int lid = (fq << 4) | fr;
                    ps += __int_as_float(__builtin_amdgcn_ds_bpermute((lid ^ 16) << 2, __float_as_int(ps))); ps2 += __int_as_float(__builtin_amdgcn_ds_bpermute((lid ^ 16) << 2, __float_as_int(ps2)));
                    ps = swap_add(ps); ps2 = swap_add(ps2);
                    if (fq == 0) *(f32x2*)(STAT + (size_t)(row0 + ai * 128 + m * 16) * 32 + (((pn - 8) & 3) * 4 + wc) * 2) = (f32x2){ps, ps2}; } }
    }
};
struct EpiProj {
    bf16_t* Gs; float* Sb; bf16_t* MIXPRE; const float* bgate;
    __device__ __forceinline__ void operator()(const f32x4 (&acc)[2][2][4][2], const Unit& u, int wr, int wc, int fr, int fq) const {
        const int tile = u.pm * 4 + u.pn, tid = (wr * 4 + wc) * 64 + fq * 16 + fr, br = u.j >> 1;
        const int row0 = u.pm * 256 + wr * 64 + fr, col00 = u.pn * 256 + wc * 32 + 8 * fq;
        if ((u.j & 1) == 0) {
#pragma unroll
            for (int bj = 0; bj < 2; ++bj) { const f32x4 b0 = *(const f32x4*)(bgate + br * 1024 + col00 + bj * 128), b1 = *(const f32x4*)(bgate + br * 1024 + col00 + bj * 128 + 4);
#pragma unroll
                for (int ai = 0; ai < 2; ++ai)
#pragma unroll
                    for (int m = 0; m < 4; ++m) { f32x4 v0 = acc[ai][bj][m][0] + b0, v1 = acc[ai][bj][m][1] + b1;
#pragma unroll
                        for (int i = 0; i < 4; ++i) { v0[i] = fast_sigmoid(v0[i]); v1[i] = fast_sigmoid(v1[i]); }
                        u32x4 w; w.x = cvt_pk_bf16(v0[0], v0[1]); w.y = cvt_pk_bf16(v0[2], v0[3]); w.z = cvt_pk_bf16(v1[0], v1[1]); w.w = cvt_pk_bf16(v1[2], v1[3]);
                        *((u32x4*)Gs + ((size_t)(tile * 16 + (ai * 2 + bj) * 4 + m) * NTHREADS + tid)) = w; } }
            return;
        }
#pragma unroll
        for (int ai = 0; ai < 2; ++ai)
#pragma unroll
            for (int bj = 0; bj < 2; ++bj)
#pragma unroll
                for (int m = 0; m < 4; ++m) {
                    const u32x4 g = *((const u32x4*)Gs + ((size_t)(tile * 16 + (ai * 2 + bj) * 4 + m) * NTHREADS + tid));
                    f32x4 y0 = acc[ai][bj][m][0], y1 = acc[ai][bj][m][1];
                    y0[0] *= bf_lo(g.x); y0[1] *= bf_hi(g.x); y0[2] *= bf_lo(g.y); y0[3] *= bf_hi(g.y);
                    y1[0] *= bf_lo(g.z); y1[1] *= bf_hi(g.z); y1[2] *= bf_lo(g.w); y1[3] *= bf_hi(g.w);
                    u32x4* sp = (u32x4*)Sb + ((size_t)(tile * 16 + (ai * 2 + bj) * 4 + m) * NTHREADS + tid);
                    if (br != 0) { const u32x4 t = *sp;
                        y0[0] += bf_lo(t.x); y0[1] += bf_hi(t.x); y0[2] += bf_lo(t.y); y0[3] += bf_hi(t.y); y1[0] += bf_lo(t.z); y1[1] += bf_hi(t.z); y1[2] += bf_lo(t.w); y1[3] += bf_hi(t.w); }
                    u32x4 w; w.x = cvt_pk_bf16(y0[0], y0[1]); w.y = cvt_pk_bf16(y0[2], y0[3]); w.z = cvt_pk_bf16(y1[0], y1[1]); w.w = cvt_pk_bf16(y1[2], y1[3]);
                    if (br != 2) *sp = w;
                    else {
                        *(u32x4*)(MIXPRE + (size_t)(row0 + ai * 128 + m * 16) * DM + col00 + bj * 128) = w; }
                }
    }
};
struct EpiF32 {
    float* O; int ldc;
    __device__ __forceinline__ void operator()(const f32x4 (&acc)[2][2][4][2], const Unit& u, int wr, int wc, int fr, int fq) const {
        const int row0 = u.pm * 256 + wr * 64 + fr, col0 = u.pn * 256 + wc * 32 + 8 * fq;
#pragma unroll
        for (int ai = 0; ai < 2; ++ai)
#pragma unroll
            for (int m = 0; m < 4; ++m) { float* rowp = O + (size_t)(row0 + ai * 128 + m * 16) * ldc + col0;
#pragma unroll
                for (int bj = 0; bj < 2; ++bj) { *(f32x4*)(rowp + bj * 128) = acc[ai][bj][m][0]; *(f32x4*)(rowp + bj * 128 + 4) = acc[ai][bj][m][1]; } }
    }
};
struct EpiRelu2 {
    bf16_t* O; int ldc;
    __device__ __forceinline__ void operator()(const f32x4 (&acc)[2][2][4][2], const Unit& u, int wr, int wc, int fr, int fq) const {
        const int row0 = u.pm * 256 + wr * 64 + fr, col0 = u.pn * 256 + wc * 32 + 8 * fq;
#pragma unroll
        for (int ai = 0; ai < 2; ++ai)
#pragma unroll
            for (int m = 0; m < 4; ++m) { bf16_t* rowp = O + (size_t)(row0 + ai * 128 + m * 16) * ldc + col0;
#pragma unroll
                for (int bj = 0; bj < 2; ++bj) { f32x4 v0 = acc[ai][bj][m][0], v1 = acc[ai][bj][m][1];
#pragma unroll
                    for (int i = 0; i < 4; ++i) { const float a = fmaxf(v0[i], 0.f), b = fmaxf(v1[i], 0.f); v0[i] = a * a; v1[i] = b * b; }
                    u32x4 w; w.x = cvt_pk_bf16(v0[0], v0[1]); w.y = cvt_pk_bf16(v0[2], v0[3]); w.z = cvt_pk_bf16(v1[0], v1[1]); w.w = cvt_pk_bf16(v1[2], v1[3]);
                    *(u32x4*)(rowp + bj * 128) = w; } }
    }
};


constexpr int EN_P = 135168, EN_S = EN_P + 4096, EN_F = EN_S + 1024;
struct EpiNormRes {
    const float* xin; float* xout; const float* gpost; const float* gnext; bf16_t* XN; float* xbuf; unsigned* cnt; LAS unsigned char* lds;
    __device__ __forceinline__ void exchange(const f32x4 (&acc)[2][2][4][2], const Unit& u, int e, int wr, int wc, int fr, int fq) const {
        LAS float* P = (LAS float*)(lds + EN_P); LAS float* S = (LAS float*)(lds + EN_S); volatile LAS unsigned* FL = (volatile LAS unsigned*)(lds + EN_F);
        const int lid = (fq << 4) | fr, wid = wr * 4 + wc, tid = wid * 64 + lid;
#pragma unroll
        for (int ai = 0; ai < 2; ++ai)
#pragma unroll
            for (int m = 0; m < 4; ++m) { float q = 0.f;
#pragma unroll
                for (int bj = 0; bj < 2; ++bj)
#pragma unroll
                    for (int n = 0; n < 2; ++n) { const f32x4 v = acc[ai][bj][m][n]; q += (v[0] * v[0] + v[1] * v[1]) + (v[2] * v[2] + v[3] * v[3]); }
                q += __int_as_float(__builtin_amdgcn_ds_bpermute((lid ^ 16) << 2, __float_as_int(q))); q = swap_add(q);
                if (fq == 0) P[(ai * 128 + wr * 64 + m * 16 + fr) * 4 + wc] = q; }
        __syncthreads();
        float* xb = xbuf + (size_t)e * T * 4 + (size_t)u.pm * 256 * 4; unsigned* c = cnt + (e * 64 + u.pm) * 64;
        if (tid < 256) { const float tot = (P[tid * 4] + P[tid * 4 + 1]) + (P[tid * 4 + 2] + P[tid * 4 + 3]);
            __hip_atomic_store(xb + tid * 4 + u.pn, tot, __ATOMIC_RELAXED, __HIP_MEMORY_SCOPE_AGENT); }
        asm volatile("s_waitcnt vmcnt(0)" ::: "memory");
        if (tid < 256 && lid == 0) __hip_atomic_fetch_add(c, 1u, __ATOMIC_RELAXED, __HIP_MEMORY_SCOPE_AGENT);
        if (wid == 0) { unsigned sp = 0;
            while ((unsigned)__builtin_amdgcn_readfirstlane((int)__hip_atomic_load(c, __ATOMIC_RELAXED, __HIP_MEMORY_SCOPE_AGENT)) < 16u) { __builtin_amdgcn_s_sleep(2); if (++sp > (1u << 22)) break; }
            __builtin_amdgcn_fence(__ATOMIC_ACQUIRE, "agent");
            if (lid == 0) FL[0] = 1u; }
        asm volatile("s_waitcnt vmcnt(0) lgkmcnt(0)" ::: "memory");
        __syncthreads();
        if (tid < 256) { float t4 = 0.f;
#pragma unroll
            for (int k = 0; k < 4; ++k) t4 += __hip_atomic_load(xb + tid * 4 + k, __ATOMIC_RELAXED, __HIP_MEMORY_SCOPE_AGENT);
            S[tid] = 1.0f / sqrtf(t4 * (1.f / DM) + EPS); }
        __syncthreads();
    }
    __device__ __forceinline__ void operator()(f32x4 (&acc)[2][2][4][2], const Unit& u, int wr, int wc, int fr, int fq) const {
        const LAS float* S = (const LAS float*)(lds + EN_S);
        const int col0 = u.pn * 256 + wc * 32 + 8 * fq;
        exchange(acc, u, 0, wr, wc, fr, fq);
#pragma unroll
        for (int ai = 0; ai < 2; ++ai)
#pragma unroll
            for (int m = 0; m < 4; ++m) { const int rl = ai * 128 + wr * 64 + m * 16 + fr; const float r1 = S[rl]; const size_t off = (size_t)(u.pm * 256 + rl) * DM + col0;
#pragma unroll
                for (int bj = 0; bj < 2; ++bj) { const f32x4 xa = *(const f32x4*)(xin + off + bj * 128), xb = *(const f32x4*)(xin + off + bj * 128 + 4);
                    const f32x4 ga = *(const f32x4*)(gpost + col0 + bj * 128), gb = *(const f32x4*)(gpost + col0 + bj * 128 + 4);
                    const f32x4 v0 = xa + acc[ai][bj][m][0] * r1 * ga, v1 = xb + acc[ai][bj][m][1] * r1 * gb;
                    *(f32x4*)(xout + off + bj * 128) = v0; *(f32x4*)(xout + off + bj * 128 + 4) = v1; acc[ai][bj][m][0] = v0; acc[ai][bj][m][1] = v1; }
                asm volatile("" ::: "memory"); }
        if (gnext) {
            exchange(acc, u, 1, wr, wc, fr, fq);
#pragma unroll
            for (int ai = 0; ai < 2; ++ai)
#pragma unroll
                for (int m = 0; m < 4; ++m) { const int rl = ai * 128 + wr * 64 + m * 16 + fr; const float r2 = S[rl]; const size_t off = (size_t)(u.pm * 256 + rl) * DM + col0;
#pragma unroll
                    for (int bj = 0; bj < 2; ++bj) { const f32x4 ga = *(const f32x4*)(gnext + col0 + bj * 128), gb = *(const f32x4*)(gnext + col0 + bj * 128 + 4);
                        const f32x4 v0 = acc[ai][bj][m][0] * r2 * ga, v1 = acc[ai][bj][m][1] * r2 * gb;
                        u32x4 w; w.x = cvt_pk_bf16(v0[0], v0[1]); w.y = cvt_pk_bf16(v0[2], v0[3]); w.z = cvt_pk_bf16(v1[0], v1[1]); w.w = cvt_pk_bf16(v1[2], v1[3]);
                        *(u32x4*)(XN + off + bj * 128) = w; }
                    asm volatile("" ::: "memory"); }
        }
    }
};

struct Args { const float* in[26]; float* out; unsigned char* ws; int lo, hi; };
enum { I_X = 0, I_NMPRE, I_NMPOST, I_WIN, I_BGATE, I_CONVW, I_CONVB, I_CLNG, I_CLNB, I_LQ1, I_LK1, I_LQ2, I_LK2, I_SUBG, I_SLNG, I_SLNB, I_SGUW, I_SGUB,
       I_WPC, I_WPA, I_WPS, I_WOUT, I_NFPRE, I_NFPOST, I_WUP, I_WDOWN };

__device__ __forceinline__ void transpose_item(const float* W, int ld, int scol, bf16_t* WT, int K, int drow, int k0, LAS float* scr, int lane) {
    float tv[32];
#pragma unroll
    for (int i = 0; i < 32; ++i) tv[i] = W[(size_t)(k0 + 2 * i + (lane >> 5)) * ld + scol + (lane & 31)];
#pragma unroll
    for (int i = 0; i < 32; ++i) scr[(2 * i + (lane >> 5)) * 33 + (lane & 31)] = tv[i];
    asm volatile("s_waitcnt lgkmcnt(0)" ::: "memory");
    const int c = lane & 7;
#pragma unroll
    for (int j = 0; j < 4; ++j) { const int n = (lane >> 3) + 8 * j; const LAS float* s = scr + (8 * c) * 33 + n;
        u32x4 o; o.x = cvt_pk_bf16(s[0 * 33], s[1 * 33]); o.y = cvt_pk_bf16(s[2 * 33], s[3 * 33]); o.z = cvt_pk_bf16(s[4 * 33], s[5 * 33]); o.w = cvt_pk_bf16(s[6 * 33], s[7 * 33]);
        *(u32x4*)(WT + (size_t)(drow + n) * K + k0 + 8 * c) = o; }
    asm volatile("s_waitcnt lgkmcnt(0)" ::: "memory");
}
__device__ __forceinline__ int win_src_col(int rb) {
    if (rb < 16) return (rb & 1) * 1024 + 128 * (rb >> 1);
    if (rb < 32) return rb * 128;
    if (rb < 48) return rb * 128 + 1024;
    if (rb < 56) return 4096 + (rb - 48) * 128;
    return rb * 128;
}
typedef const __attribute__((address_space(4))) Args* CArgsW;
__device__ __forceinline__ void convert_weights(CArgsW a, int layer, LAS unsigned char* lds, int gw, int NGW, int wave, int lane) {
    LAS float* scr = (LAS float*)(lds + wave * 16384);
    bf16_t* W = (bf16_t*)(a->ws + WS_W);
    constexpr int I_IN = 16 * 320, I_SQ = 16 * 32, I_U = 16 * 128, I_D = 64 * 32, NIT = I_IN + 4 * I_SQ + I_U + I_D;
    for (int it = gw; it < NIT; it += NGW) {
        int r = it;
        if (r < I_IN) { const int kb = r / 320, nb = r % 320; transpose_item(a->in[I_WIN] + (size_t)layer * DM * WIN, WIN, win_src_col(nb >> 2) + (nb & 3) * 32, W + WO_IN, DM, nb * 32, kb * 64, scr, lane); continue; }
        r -= I_IN;
        if (r < 4 * I_SQ) { const int w = r / I_SQ, q = r % I_SQ, kb = q / 32, nb = q % 32;
            const float* src = a->in[w == 0 ? I_WPC : w == 1 ? I_WPA : w == 2 ? I_WPS : I_WOUT] + (size_t)layer * DM * DM;
            transpose_item(src, DM, nb * 32, W + WO_PC + (size_t)w * DM * DM, DM, nb * 32, kb * 64, scr, lane); continue; }
        r -= 4 * I_SQ;
        if (r < I_U) { const int kb = r / 128, nb = r % 128; transpose_item(a->in[I_WUP] + (size_t)layer * DM * DFF, DFF, nb * 32, W + WO_UP, DM, nb * 32, kb * 64, scr, lane); continue; }
        r -= I_U;
        { const int kb = r / 32, nb = r % 32; transpose_item(a->in[I_WDOWN] + (size_t)layer * DFF * DM, DM, nb * 32, W + WO_DOWN, DFF, nb * 32, kb * 64, scr, lane); }
    }
}

__device__ __forceinline__ void rms_rows4_to_bf16(const float* x0row, size_t rstride, const float* g, bf16_t* o0row, int lane) {
    f32x4 v[4][4]; float s[4];
#pragma unroll
    for (int r = 0; r < 4; ++r) { const f32x4* xr = (const f32x4*)(x0row + r * rstride) + lane; s[r] = 0.f;
#pragma unroll
        for (int j = 0; j < 4; ++j) v[r][j] = xr[64 * j]; }
#pragma unroll
    for (int r = 0; r < 4; ++r)
#pragma unroll
        for (int j = 0; j < 4; ++j) s[r] += (v[r][j].x * v[r][j].x + v[r][j].y * v[r][j].y) + (v[r][j].z * v[r][j].z + v[r][j].w * v[r][j].w);
    { int lid = lane_id(); asm volatile("" : "+v"(lid));
#pragma unroll
      for (int o = 1; o < 64; o <<= 1)
#pragma unroll
          for (int r = 0; r < 4; ++r) s[r] += __int_as_float(__builtin_amdgcn_ds_bpermute((lid ^ o) << 2, __float_as_int(s[r]))); }
    const f32x4* gr = (const f32x4*)g + lane;
#pragma unroll
    for (int r = 0; r < 4; ++r) { const float rstd = __builtin_amdgcn_rsqf(s[r] * (1.f / DM) + EPS); u32x2* o8 = (u32x2*)(o0row + r * rstride) + lane;
#pragma unroll
        for (int j = 0; j < 4; ++j) { const f32x4 gg = gr[64 * j]; u32x2 w; w.x = cvt_pk_bf16(v[r][j].x * rstd * gg.x, v[r][j].y * rstd * gg.y); w.y = cvt_pk_bf16(v[r][j].z * rstd * gg.z, v[r][j].w * rstd * gg.w); o8[64 * j] = w; } }
}
__device__ __forceinline__ void resid_norm_row(const float* yrow, const float* xin, float* xout, const float* gpost, const float* gnext, bf16_t* xn, int lane) {
    const f32x4* yr = (const f32x4*)yrow + lane; const f32x4* xr = (const f32x4*)xin + lane; const f32x4* gp = (const f32x4*)gpost + lane;
    f32x4 v[4]; float s = 0.f;
#pragma unroll
    for (int j = 0; j < 4; ++j) { v[j] = yr[64 * j]; s += (v[j].x * v[j].x + v[j].y * v[j].y) + (v[j].z * v[j].z + v[j].w * v[j].w); }
    const float rstd = 1.f / sqrtf(wave_sum(s) * (1.f / DM) + EPS);
    float s2 = 0.f;
#pragma unroll
    for (int j = 0; j < 4; ++j) { const f32x4 xx = xr[64 * j], gg = gp[64 * j]; v[j] = xx + v[j] * rstd * gg; s2 += (v[j].x * v[j].x + v[j].y * v[j].y) + (v[j].z * v[j].z + v[j].w * v[j].w); }
    f32x4* xo = (f32x4*)xout + lane;
#pragma unroll
    for (int j = 0; j < 4; ++j) xo[64 * j] = v[j];
    if (gnext) {
        const float r2 = 1.f / sqrtf(wave_sum(s2) * (1.f / DM) + EPS);
        const f32x4* gn = (const f32x4*)gnext + lane; u32x2* o8 = (u32x2*)xn + lane;
#pragma unroll
        for (int j = 0; j < 4; ++j) { const f32x4 gg = gn[64 * j]; u32x2 w; w.x = cvt_pk_bf16(v[j].x * r2 * gg.x, v[j].y * r2 * gg.y); w.y = cvt_pk_bf16(v[j].z * r2 * gg.z, v[j].w * r2 * gg.w); o8[64 * j] = w; }
    }
}

__device__ __forceinline__ void conv_run(LAS unsigned char* lds, const bf16_t* AG, bf16_t* CA, const float* cw, const float* cb, const float* lng, const float* lnb, int unit0, int nun, const int wave_s) {
    const int tid_ = wave_s * 64 + lane_op();
    const int tid = tid_, lane = tid & 63, wid = wave_s;
    const int c = 2 * tid;
    f32x2 in[46]; unsigned nx[16];
    LAS float* red = (LAS float*)lds;
    LAS float* stat = (LAS float*)(lds + 65536);
    const f32x2 bias = *(const f32x2*)(cb + c);
    const f32x2 g = *(const f32x2*)(lng + c), bb = *(const f32x2*)(lnb + c);
    LAS unsigned* wl = (LAS unsigned*)(lds + 65536 + 256);
#pragma unroll
    for (int j = 0; j < 31; ++j) { const f32x2 w = *(const f32x2*)(cw + j * DM + c); wl[j * 512 + tid] = cvt_pk_bf16(w.x, w.y); }
    for (int u = 0; u < nun; ++u) {
        const int tok0 = (unit0 + u) * 16, b = tok0 >> 11, s0 = tok0 & 2047;
        if (u == 0) {
#pragma unroll
            for (int i = 0; i < 46; ++i) { const int s = s0 - 15 + i;
                if (s >= 0 && s < SEQ) { const unsigned v = *(const unsigned*)(AG + (size_t)(b * SEQ + s) * DM + c); in[i] = (f32x2){bf_lo(v), bf_hi(v)}; } else in[i] = (f32x2){0.f, 0.f}; }
        } else {
#pragma unroll
            for (int i = 0; i < 30; ++i) in[i] = in[i + 16];
#pragma unroll
            for (int i = 0; i < 16; ++i) in[30 + i] = (f32x2){bf_lo(nx[i]), bf_hi(nx[i])};
        }
        if (u + 1 < nun) {
#pragma unroll
            for (int i = 0; i < 16; ++i) { const int s = s0 + 31 + i; nx[i] = (s < SEQ) ? *(const unsigned*)(AG + (size_t)(b * SEQ + s) * DM + c) : 0u; }
        }
        f32x2 acc[16];
#pragma unroll
        for (int t = 0; t < 16; ++t) acc[t] = bias;
#pragma unroll
        for (int j = 0; j < 31; ++j) { const unsigned wp = wl[j * 512 + tid]; const f32x2 w = (f32x2){bf_lo(wp), bf_hi(wp)};
#pragma unroll
            for (int t = 0; t < 16; ++t) acc[t] += w * in[t + j]; }
#pragma unroll
        for (int t = 0; t < 16; ++t) { red[(2 * t) * 512 + tid] = acc[t].x + acc[t].y; red[(2 * t + 1) * 512 + tid] = acc[t].x * acc[t].x + acc[t].y * acc[t].y; }
        __syncthreads();
#pragma unroll
        for (int r = 0; r < 2; ++r) { const int tk = wid * 2 + r; float sm = 0.f, sq = 0.f;
#pragma unroll
            for (int i = 0; i < 8; ++i) { sm += red[(2 * tk) * 512 + lane + 64 * i]; sq += red[(2 * tk + 1) * 512 + lane + 64 * i]; }
            sm = wave_sum(sm); sq = wave_sum(sq);
            if (lane == 0) { const float mean = sm * (1.f / DM), var = sq * (1.f / DM) - mean * mean; stat[2 * tk] = mean; stat[2 * tk + 1] = __builtin_amdgcn_rsqf(var + EPS); } }
        __syncthreads();
#pragma unroll
        for (int t = 0; t < 16; ++t) { const float mean = stat[2 * t], rstd = stat[2 * t + 1];
            const float y0 = (acc[t].x - mean) * rstd * g.x + bb.x, y1 = (acc[t].y - mean) * rstd * g.y + bb.y;
            *(unsigned*)(CA + (size_t)(tok0 + t) * DM + c) = cvt_pk_bf16(y0 * fast_sigmoid(y0), y1 * fast_sigmoid(y1)); }
        __syncthreads();
    }
}

constexpr int SG_WL = 0, SG_GL = 128 * 272, SG_ST = 2 * 128 * 272;
template <bool STORE> __device__ __forceinline__ void sgu_unit(LAS unsigned char* lds, const bf16_t* GEL, const float* STAT, bf16_t* GU, const float* sw, const float* sb, const float* lng, const float* lnb, int unit, const int wave_s) {
    const int tid_ = wave_s * 64 + lane_op();
    const int tid = tid_, lane = tid & 63, wid = wave_s;
    const int chunk = unit >> 3, g = unit & 7, tok0 = chunk * 128, c0 = g * 128;
    LAS float* st = (LAS float*)(lds + SG_ST);
    const int cb = wid & 3, th = wid >> 2, q = lane & 31, hi = lane >> 5;
    u32x2 gu8[2][4]; float sbias[2];
#pragma unroll
    for (int tb = 0; tb < 2; ++tb) { const int t = 64 * th + 32 * tb + q; sbias[tb] = sb[g * 128 + t]; const bf16_t* rp = GU + (size_t)(tok0 + t) * DM + c0 + 32 * cb + 4 * hi;
#pragma unroll
        for (int i = 0; i < 4; ++i) gu8[tb][i] = *(const u32x2*)(rp + 8 * i); }
    u32x4 gv4[4];
#pragma unroll
    for (int i = 0; i < 4; ++i) { const int id = tid + 512 * i; gv4[i] = *(const u32x4*)(GEL + (size_t)(tok0 + (id >> 4)) * DM + c0 + (id & 15) * 8); }
    if (tid < 128) { const f32x4* sp = (const f32x4*)(STAT + (size_t)(tok0 + tid) * 32); float s = 0.f, s2 = 0.f;
#pragma unroll
        for (int i = 0; i < 8; ++i) { const f32x4 v = sp[i]; s += v[0] + v[2]; s2 += v[1] + v[3]; }
        const float mean = s * (1.f / DM), var = s2 * (1.f / DM) - mean * mean; st[2 * tid] = mean; st[2 * tid + 1] = __builtin_amdgcn_rsqf(var + EPS); }
#pragma unroll
    for (int i = 0; i < 8; ++i) { const int id = tid + 512 * i, t = id >> 5, s4 = (id & 31) * 4; const f32x4 v = *(const f32x4*)(sw + (size_t)g * 16384 + t * 128 + s4);
        u32x2 w; w.x = cvt_pk_bf16(v[0], v[1]); w.y = cvt_pk_bf16(v[2], v[3]); *(LAS u32x2*)(lds + SG_WL + t * 272 + s4 * 2) = w; }
    __syncthreads();
#pragma unroll
    for (int i = 0; i < 4; ++i) { const int id = tid + 512 * i, s = id >> 4, cc = (id & 15) * 8; const u32x4 v = gv4[i];
        const float mean = st[2 * s], rstd = st[2 * s + 1];
        const f32x4 g0 = *(const f32x4*)(lng + c0 + cc), g1 = *(const f32x4*)(lng + c0 + cc + 4), b0 = *(const f32x4*)(lnb + c0 + cc), b1 = *(const f32x4*)(lnb + c0 + cc + 4);
        float x[8] = {bf_lo(v.x), bf_hi(v.x), bf_lo(v.y), bf_hi(v.y), bf_lo(v.z), bf_hi(v.z), bf_lo(v.w), bf_hi(v.w)};
#pragma unroll
        for (int k = 0; k < 8; ++k) { const float gg = k < 4 ? g0[k & 3] : g1[k & 3], bb = k < 4 ? b0[k & 3] : b1[k & 3]; const float y = (x[k] - mean) * rstd * gg + bb;
            *(LAS bf16_t*)(lds + SG_GL + (cc + k) * 272 + s * 2) = (bf16_t)(cvt_pk_bf16(y, 0.f) & 0xffffu); } }
    __syncthreads();
    f32x16 d0 = {}, d1 = {};
#pragma unroll
    for (int ks = 0; ks < 8; ++ks) {
        const bf16x8 af = *(const LAS bf16x8*)(lds + SG_GL + (32 * cb + q) * 272 + (16 * ks + 8 * hi) * 2);
        const bf16x8 b0 = *(const LAS bf16x8*)(lds + SG_WL + (64 * th + q) * 272 + (16 * ks + 8 * hi) * 2);
        const bf16x8 b1 = *(const LAS bf16x8*)(lds + SG_WL + (64 * th + 32 + q) * 272 + (16 * ks + 8 * hi) * 2);
        d0 = __builtin_amdgcn_mfma_f32_32x32x16_bf16(af, b0, d0, 0, 0, 0);
        d1 = __builtin_amdgcn_mfma_f32_32x32x16_bf16(af, b1, d1, 0, 0, 0);
    }
#pragma unroll
    for (int tb = 0; tb < 2; ++tb) { const int t = 64 * th + 32 * tb + q; const float bias = sbias[tb];
        bf16_t* rowp = GU + (size_t)(tok0 + t) * DM + c0 + 32 * cb + 4 * hi;
#pragma unroll
        for (int i = 0; i < 4; ++i) { const u32x2 u = gu8[tb][i];
            const float m0 = (tb ? d1[4 * i] : d0[4 * i]) + bias, m1 = (tb ? d1[4 * i + 1] : d0[4 * i + 1]) + bias, m2 = (tb ? d1[4 * i + 2] : d0[4 * i + 2]) + bias, m3 = (tb ? d1[4 * i + 3] : d0[4 * i + 3]) + bias;
            u32x2 w; w.x = cvt_pk_bf16(bf_lo(u.x) * m0, bf_hi(u.x) * m1); w.y = cvt_pk_bf16(bf_lo(u.y) * m2, bf_hi(u.y) * m3);
            if (STORE) *(u32x2*)(rowp + 8 * i) = w; } }
    __syncthreads();
}

constexpr int AT_SLOT = 16384, AT_VOFF = 4 * AT_SLOT;
__device__ __forceinline__ float max3f(float a, float b, float c) { return __builtin_fmaxf(__builtin_fmaxf(a, b), c); }
__device__ __forceinline__ void glds16(const void* gsrc, unsigned lds_dst) { unsigned keep;
    asm volatile("s_mov_b32 %0, m0\n\ts_mov_b32 m0, %2\n\ts_nop 0\n\tglobal_load_lds_dwordx4 %1, off\n\ts_mov_b32 m0, %0" : "=&s"(keep) : "v"(gsrc), "s"(lds_dst) : "memory"); }
template <bool STORE> __device__ __forceinline__ void attn_unit(LAS unsigned char* lds, bf16_t* Q, const bf16_t* Kg, const bf16_t* VT, const float* subg, float lam, float outscale, int unit, const int wave_s) {
    const int tid_ = wave_s * 64 + lane_op();
    const int tid = tid_, lane = tid & 63, wid = wave_s, q = lane & 31, hi = lane >> 5;
    const int bh = unit >> 4, qb = unit & 15, b = bh >> 3, h = bh & 7, map = wid >> 2;
    const int qrow0 = qb * 128 + 32 * (wid & 3);
    const int td = qrow0 >> 6;
    bf16x8 qf[4];
    { const bf16_t* Qp = Q + (size_t)(b * SEQ + qrow0 + q) * DM + h * 128 + map * 64 + 8 * hi;
#pragma unroll
      for (int d0 = 0; d0 < 4; ++d0) qf[d0] = *(const bf16x8*)(Qp + 16 * d0); }
    const float sl = __int_as_float(__builtin_amdgcn_readfirstlane(__float_as_int(exp2f(-(float)(h + 1)) * LOG2E)));
    const unsigned lds0 = (unsigned)(uintptr_t)lds;
    const bf16_t* kgp; const bf16_t* vgp;
    { const int kr = 8 * wid + (lane >> 4), kc = (lane & 15) ^ (kr & 15); kgp = Kg + (size_t)(b * SEQ + kr) * DM + h * 128 + kc * 8;
      const int vr = 16 * wid + (lane >> 3), vc = (lane & 7) ^ ((vr >> 1) & 7); vgp = VT + (size_t)(h * 128 + vr) * T + b * SEQ + vc * 8; }
    const int kx1 = ((((lane & 15) ^ ((8 * wid + (lane >> 4) + 4) & 15)) - ((lane & 15) ^ ((8 * wid + (lane >> 4)) & 15))) * 8) + 4 * DM;
    const int vx1 = ((((lane & 7) ^ (((16 * wid + (lane >> 3) + 8) >> 1) & 7)) - ((lane & 7) ^ (((16 * wid + (lane >> 3)) >> 1) & 7))) * 8) + 8 * T;
    const unsigned kdst = lds0 + wid * 2048, vdst = lds0 + AT_VOFF + wid * 2048;
#define AT_ISSUE_K(tt) do { const unsigned so_ = (unsigned)(((tt) & 3) * AT_SLOT); const bf16_t* kp_ = kgp + (size_t)(tt) * 64 * DM; \
        glds16(kp_, (unsigned)__builtin_amdgcn_readfirstlane(kdst + so_)); glds16(kp_ + kx1, (unsigned)__builtin_amdgcn_readfirstlane(kdst + so_ + 1024)); } while (0)
#define AT_ISSUE_V(tt) do { const unsigned so_ = (unsigned)(((tt) & 3) * AT_SLOT); const bf16_t* vp_ = vgp + (tt) * 64; \
        glds16(vp_, (unsigned)__builtin_amdgcn_readfirstlane(vdst + so_)); glds16(vp_ + vx1, (unsigned)__builtin_amdgcn_readfirstlane(vdst + so_ + 1024)); } while (0)
#define AT_BAR(N) asm volatile("s_waitcnt vmcnt(" #N ") lgkmcnt(0)\n\ts_barrier" ::: "memory")
    AT_ISSUE_K(0); AT_ISSUE_V(0); AT_ISSUE_K(1); AT_ISSUE_V(1); AT_ISSUE_K(2); AT_ISSUE_V(2); AT_ISSUE_K(3);
    AT_BAR(8);
    f32x16 o[4]; o[0] = f32x16{}; o[1] = f32x16{}; o[2] = f32x16{}; o[3] = f32x16{};
    float mref = 0.f, lsum = 0.f;
    const int koff = q * 256 + (((map * 8 + hi) ^ (q & 15)) << 4), voff = AT_VOFF + q * 128 + ((hi ^ ((q >> 1) & 7)) << 4);
    const float qposf = (float)(qrow0 + q - 4 * hi);
    f32x16 x0, x1, n0, n1;
#define AT_CINIT(tt, sgn, c0, c1) do { const float ss_ = (sgn) * sl, s2_ = ss_ + ss_, s3_ = s2_ + ss_, s4_ = s2_ + s2_, s8_ = s4_ + s4_, s16_ = s8_ + s8_; float g0_ = ss_ * ((float)(64 * (tt)) - qposf) - mref, g1_ = g0_ + (s16_ + s16_); \
        _Pragma("unroll") for (int g = 0; g < 4; ++g) { c0[4 * g] = g0_; c0[4 * g + 1] = g0_ + ss_; c0[4 * g + 2] = g0_ + s2_; c0[4 * g + 3] = g0_ + s3_; \
            c1[4 * g] = g1_; c1[4 * g + 1] = g1_ + ss_; c1[4 * g + 2] = g1_ + s2_; c1[4 * g + 3] = g1_ + s3_; g0_ += s8_; g1_ += s8_; } } while (0)
#define AT_QK(kslot, c0, c1) do { _Pragma("unroll") for (int d0 = 0; d0 < 4; ++d0) { \
        const bf16x8 k0_ = *(const LAS bf16x8*)(lds + (kslot) + (koff ^ (d0 << 5))); const bf16x8 k1_ = *(const LAS bf16x8*)(lds + (kslot) + (koff ^ (d0 << 5)) + 8192); \
        c0 = __builtin_amdgcn_mfma_f32_32x32x16_bf16(k0_, qf[d0], c0, 0, 0, 0); c1 = __builtin_amdgcn_mfma_f32_32x32x16_bf16(k1_, qf[d0], c1, 0, 0, 0); } } while (0)
#define AT_DIAG(tt, c0, c1) do { const float base_ = qposf - (float)(64 * (tt)); \
        _Pragma("unroll") for (int r = 0; r < 16; ++r) { const float cr_ = (float)((r & 3) + 8 * (r >> 2)); c0[r] -= sl * fabsf(base_ - cr_); c1[r] -= sl * fabsf(base_ - 32.f - cr_); } } while (0)
#define AT_MAX(c0, c1, rm) do { float a_ = fmaxf(c0[0], c1[0]), b_ = fmaxf(c0[1], c1[1]); \
        _Pragma("unroll") for (int r = 2; r < 16; r += 2) { a_ = max3f(a_, c0[r], c1[r]); b_ = max3f(b_, c0[r + 1], c1[r + 1]); } rm = swap_max(fmaxf(a_, b_)); } while (0)
    { const float sg0 = td > 0 ? 1.f : 0.f;
      AT_CINIT(0, sg0, x0, x1); AT_QK(0, x0, x1);
      if (td == 0) AT_DIAG(0, x0, x1);
      float rm; AT_MAX(x0, x1, rm); mref = rm;
#pragma unroll
      for (int r = 0; r < 16; ++r) { x0[r] -= rm; x1[r] -= rm; } }
    asm volatile("s_waitcnt lgkmcnt(0)\n\ts_barrier" ::: "memory");
#define AT_SB() __builtin_amdgcn_sched_barrier(0)
#define AT_VRD(dst, kk) do { _Pragma("unroll") for (int d = 0; d < 4; ++d) dst[d] = *(const LAS bf16x8*)(lds + vcur_ + (voff ^ ((kk) << 5)) + d * 4096); } while (0)
#define AT_PV(src, kk) do { const bf16x8 pf_ = __builtin_bit_cast(bf16x8, pw_[kk]); _Pragma("unroll") for (int d = 0; d < 4; ++d) o[d] = __builtin_amdgcn_mfma_f32_32x32x16_bf16(src[d], pf_, o[d], 0, 0, 0); } while (0)
#define AT_BODY(MODE, t, SGN, x0, x1, n0, n1) do { \
        const bool pre_ = ((MODE) != 2) && ((t) + 4 < 32); \
        if (pre_) { AT_ISSUE_K((t) + 4); AT_ISSUE_V((t) + 3); } else if (((MODE) != 2) && ((t) + 3 < 32)) { AT_ISSUE_V((t) + 3); } \
        bf16x8 kf_[4], kg_[4], va_[4], vb_[4]; const int ks_ = (((t) + 1) & 3) * AT_SLOT, vcur_ = ((t) & 3) * AT_SLOT; \
        if ((MODE) != 2) { \
            _Pragma("unroll") for (int d0 = 0; d0 < 2; ++d0) { kf_[2 * d0] = *(const LAS bf16x8*)(lds + ks_ + (koff ^ (d0 << 5))); kf_[2 * d0 + 1] = *(const LAS bf16x8*)(lds + ks_ + (koff ^ (d0 << 5)) + 8192); } \
            AT_CINIT((t) + 1, ((MODE) == 1 ? 0.f : (SGN)), n0, n1); } \
        AT_SB(); \
        if ((MODE) != 2) { \
            _Pragma("unroll") for (int d0 = 0; d0 < 2; ++d0) { kg_[2 * d0] = *(const LAS bf16x8*)(lds + ks_ + (koff ^ ((d0 + 2) << 5))); kg_[2 * d0 + 1] = *(const LAS bf16x8*)(lds + ks_ + (koff ^ ((d0 + 2) << 5)) + 8192); } \
            _Pragma("unroll") for (int d0 = 0; d0 < 2; ++d0) { n0 = __builtin_amdgcn_mfma_f32_32x32x16_bf16(kf_[2 * d0], qf[d0], n0, 0, 0, 0); n1 = __builtin_amdgcn_mfma_f32_32x32x16_bf16(kf_[2 * d0 + 1], qf[d0], n1, 0, 0, 0); } \
            _Pragma("unroll") for (int d0 = 0; d0 < 2; ++d0) { n0 = __builtin_amdgcn_mfma_f32_32x32x16_bf16(kg_[2 * d0], qf[d0 + 2], n0, 0, 0, 0); n1 = __builtin_amdgcn_mfma_f32_32x32x16_bf16(kg_[2 * d0 + 1], qf[d0 + 2], n1, 0, 0, 0); } } \
        AT_VRD(va_, 0); \
        float ps_ = 0.f; u32x4 pw_[4]; \
        _Pragma("unroll") for (int r = 0; r < 16; ++r) { x0[r] = __builtin_amdgcn_exp2f(x0[r]); x1[r] = __builtin_amdgcn_exp2f(x1[r]); ps_ += x0[r] + x1[r]; } \
        lsum += ps_; \
        pw_[0].x = cvt_pk_bf16(x0[0], x0[1]); pw_[0].y = cvt_pk_bf16(x0[2], x0[3]); pw_[0].z = cvt_pk_bf16(x0[4], x0[5]); pw_[0].w = cvt_pk_bf16(x0[6], x0[7]); \
        pw_[1].x = cvt_pk_bf16(x0[8], x0[9]); pw_[1].y = cvt_pk_bf16(x0[10], x0[11]); pw_[1].z = cvt_pk_bf16(x0[12], x0[13]); pw_[1].w = cvt_pk_bf16(x0[14], x0[15]); \
        pw_[2].x = cvt_pk_bf16(x1[0], x1[1]); pw_[2].y = cvt_pk_bf16(x1[2], x1[3]); pw_[2].z = cvt_pk_bf16(x1[4], x1[5]); pw_[2].w = cvt_pk_bf16(x1[6], x1[7]); \
        pw_[3].x = cvt_pk_bf16(x1[8], x1[9]); pw_[3].y = cvt_pk_bf16(x1[10], x1[11]); pw_[3].z = cvt_pk_bf16(x1[12], x1[13]); pw_[3].w = cvt_pk_bf16(x1[14], x1[15]); \
        AT_SB(); \
        AT_VRD(vb_, 1); AT_PV(va_, 0); AT_SB(); \
        AT_VRD(va_, 2); AT_PV(vb_, 1); AT_SB(); \
        float rm_ = 0.f; \
        AT_VRD(vb_, 3); AT_PV(va_, 2); \
        if ((MODE) != 2) { if ((MODE) == 1) AT_DIAG((t) + 1, n0, n1); AT_MAX(n0, n1, rm_); } \
        AT_SB(); \
        AT_PV(vb_, 3); \
        if ((MODE) != 2) { \
            if (__any(rm_ > 8.0f)) { const float dl_ = fmaxf(rm_, 0.f); mref += dl_; const float al_ = __builtin_amdgcn_exp2f(-dl_); lsum *= al_; \
                _Pragma("unroll") for (int r = 0; r < 16; ++r) { n0[r] -= dl_; n1[r] -= dl_; } \
                _Pragma("unroll") for (int d = 0; d < 4; ++d) _Pragma("unroll") for (int r = 0; r < 16; ++r) o[d][r] *= al_; } \
            } \
        if (pre_) AT_BAR(8); else AT_BAR(0); } while (0)
    {
        int t = 0;
        for (; t + 2 < td; t += 2) { AT_BODY(0, t, 1.0f, x0, x1, n0, n1); AT_BODY(0, t + 1, 1.0f, n0, n1, x0, x1); }
        if (t + 1 < td) { AT_BODY(0, t, 1.0f, x0, x1, n0, n1); x0 = n0; x1 = n1; ++t; }
        if (td >= 1) { AT_BODY(1, t, 0.0f, x0, x1, n0, n1); x0 = n0; x1 = n1; ++t; }
        for (; t + 1 < 31; t += 2) { AT_BODY(0, t, -1.0f, x0, x1, n0, n1); AT_BODY(0, t + 1, -1.0f, n0, n1, x0, x1); }
        if (t < 31) { AT_BODY(0, t, -1.0f, x0, x1, n0, n1); x0 = n0; x1 = n1; ++t; }
        AT_BODY(2, 31, 0.0f, x0, x1, n0, n1);
    }
#undef AT_BODY
#undef AT_ISSUE_K
#undef AT_ISSUE_V
#undef AT_BAR
#undef AT_SB
#undef AT_VRD
#undef AT_PV
#undef AT_CINIT
#undef AT_QK
#undef AT_DIAG
#undef AT_MAX
    const float inv = 1.0f / swap_add(lsum);
    LAS float* xb = (LAS float*)lds + (wid & 3) * 4096;
    if (map == 1) {
#pragma unroll
        for (int d = 0; d < 4; ++d)
#pragma unroll
            for (int r = 0; r < 16; ++r) xb[(d * 16 + r) * 64 + lane] = o[d][r] * inv;
    }
    __syncthreads();
    if (STORE && map == 0) {
        float ss = 0.f;
#pragma unroll
        for (int d = 0; d < 4; ++d)
#pragma unroll
            for (int r = 0; r < 16; ++r) { const float v = o[d][r] * inv - lam * xb[(d * 16 + r) * 64 + lane]; o[d][r] = v; ss += v * v; }
        ss = swap_add(ss);
        const float rstd = outscale / sqrtf(ss * (1.f / 128.f) + EPS);
        const int l2 = lane_op();
        bf16_t* orow = Q + (size_t)(b * SEQ + qrow0 + (l2 & 31)) * DM + h * 128 + 4 * (l2 >> 5);
        f32x4 gg[4][4];
#pragma unroll
        for (int d = 0; d < 4; ++d)
#pragma unroll
            for (int i = 0; i < 4; ++i) gg[d][i] = *(const f32x4*)(subg + 32 * d + 8 * i + 4 * (l2 >> 5));
#pragma unroll
        for (int d = 0; d < 4; ++d)
#pragma unroll
            for (int i = 0; i < 4; ++i) {
                u32x2 w; w.x = cvt_pk_bf16(o[d][4 * i] * rstd * gg[d][i][0], o[d][4 * i + 1] * rstd * gg[d][i][1]); w.y = cvt_pk_bf16(o[d][4 * i + 2] * rstd * gg[d][i][2], o[d][4 * i + 3] * rstd * gg[d][i][3]);
                *(u32x2*)(orow + 32 * d + 8 * i) = w; }
    }
    __syncthreads();
}


#define XB_TMO      128
#define XB_XCNT(j)  (256  + 64 * (j))
#define XB_XSUB(j)  (1280 + 64 * (j))
#define XB_XGEN(j)  (2304 + 64 * (j))
#define XB_TOP      3328
#define XB_TOPGEN   3392
#define XCD_BAR_WORDS 3456
#define XB_SPIN_CAP (1u << 22)
__device__ __forceinline__ unsigned xb_ld(unsigned* p)              { return __hip_atomic_load(p, __ATOMIC_RELAXED, __HIP_MEMORY_SCOPE_AGENT); }
__device__ __forceinline__ unsigned xb_add(unsigned* p, unsigned v) { return __hip_atomic_fetch_add(p, v, __ATOMIC_RELAXED, __HIP_MEMORY_SCOPE_AGENT); }
__device__ __forceinline__ unsigned xb_xcc_id() { return (unsigned)__builtin_amdgcn_s_getreg((3 << 11) | 20) & 0xFu; }
#define XB_SPIN(cond, bar) do { unsigned _sp = 0; while (cond) { __builtin_amdgcn_s_sleep(1); \
    if ((++_sp & 255u) == 0u) { if (xb_ld(&(bar)[XB_TMO])) break; if (_sp > XB_SPIN_CAP) { atomicAdd(&(bar)[XB_TMO], 1u); break; } } } } while (0)
struct XcdBarrier { unsigned* bar; unsigned x; volatile LAS unsigned* st; };
__device__ __forceinline__ XcdBarrier xcd_barrier_post(unsigned* bar, volatile LAS unsigned* st, bool t0) {
    XcdBarrier b; b.bar = bar; b.x = xb_xcc_id(); b.st = st;
    if (t0) (void)xb_add(&bar[XB_XCNT(b.x)], 1u);
    return b;
}
__device__ __forceinline__ void xcd_barrier_complete(unsigned* bar, unsigned x, unsigned& nloc, unsigned& nx) {
    const unsigned G = gridDim.x * gridDim.y * gridDim.z;
    unsigned sum, cnt, mine, sp = 0u;
    for (;;) {
        sum = 0u; cnt = 0u; mine = 0u;
#pragma unroll
        for (unsigned j = 0; j < 16; ++j) { const unsigned c = xb_ld(&bar[XB_XCNT(j)]); sum += c; cnt += (c > 0u) ? 1u : 0u; mine = (j == x) ? c : mine; }
        if (sum == G) break;
        __builtin_amdgcn_s_sleep(1);
        if ((++sp & 255u) == 0u) { if (xb_ld(&bar[XB_TMO])) break; if (sp > XB_SPIN_CAP) { atomicAdd(&bar[XB_TMO], 1u); break; } }
    }
    nloc = mine > 0u ? mine : 1u; nx = cnt > 0u ? cnt : 1u;
}
__device__ __forceinline__ void xcd_barrier(const XcdBarrier& b, bool t0) {
    asm volatile("s_waitcnt vmcnt(0)" ::: "memory");
    __syncthreads();
    if (t0) {
        unsigned* bar = b.bar;
        __builtin_amdgcn_s_waitcnt(0);
        unsigned nloc = b.st[0], nx = b.st[1];
        if (nloc == 0u) { xcd_barrier_complete(bar, b.x, nloc, nx); b.st[0] = nloc; b.st[1] = nx; }
        const unsigned old = xb_add(&bar[XB_XSUB(b.x)], 1u);
        const unsigned gen = old / nloc;
        if (old + 1u == (gen + 1u) * nloc) {
            __builtin_amdgcn_fence(__ATOMIC_RELEASE, "agent");
            asm volatile("s_waitcnt vmcnt(0)" ::: "memory");
            const unsigned og = xb_add(&bar[XB_TOP], 1u);
            const unsigned tg = og / nx;
            if (og + 1u == (tg + 1u) * nx) xb_add(&bar[XB_TOPGEN], 1u);
            else XB_SPIN(xb_ld(&bar[XB_TOPGEN]) == tg, bar);
            __builtin_amdgcn_fence(__ATOMIC_ACQUIRE, "agent");
            xb_add(&bar[XB_XGEN(b.x)], 1u);
            asm volatile("s_waitcnt vmcnt(0)" ::: "memory");
        } else {
            XB_SPIN(xb_ld(&bar[XB_XGEN(b.x)]) == gen, bar);
            __builtin_amdgcn_fence(__ATOMIC_ACQUIRE, "agent");
            asm volatile("s_waitcnt vmcnt(0)" ::: "memory");
        }
    }
    __syncthreads();
}

constexpr int LDS_BYTES = 147456;
#ifndef PROBE_GEMM2
#define PROBE_GEMM2 0
#endif
#ifndef FUSE_NORM
#define FUSE_NORM 1
#endif
#if PROBE_GEMM2
constexpr unsigned long long SEQ_PACK = 0x7665543322100ull; constexpr int NPL = 13;
#elif FUSE_NORM
constexpr unsigned long long SEQ_PACK = 0x7653210ull; constexpr int NPL = 7;
#else
constexpr unsigned long long SEQ_PACK = 0x76543210ull; constexpr int NPL = 8;
#endif
constexpr int N_PHASES = 1 + NPL * DEPTH;
#ifndef PROBE_GEMM2
#define PROBE_GEMM2 0
#endif
#ifndef PROBE_SYNC
#define PROBE_SYNC 0
#endif
#ifndef PROBE_CONV2
#define PROBE_CONV2 0
#endif
#ifndef PROBE_P02
#define PROBE_P02 0
#endif
#ifndef PROBE_SGU2
#define PROBE_SGU2 0
#endif
#ifndef PROBE_ATT2
#define PROBE_ATT2 0
#endif
#ifndef PHMASK
#define PHMASK 0xfff
#endif

typedef const __attribute__((address_space(4))) Args* CArgs;
#define PH_ON(bit) if constexpr ((PHMASK & (bit)) != 0)
__global__ void __launch_bounds__(NTHREADS, 2) fwd_megakernel(Args a_unused) {
    extern __shared__ __attribute__((aligned(16))) unsigned char lds_raw[];
    LAS unsigned char* lds = (LAS unsigned char*)lds_raw;
    CArgs ap0 = (CArgs)__builtin_amdgcn_kernarg_segment_ptr();
    const int lo = ap0->lo, hi = ap0->hi;
    const int wave = __builtin_amdgcn_readfirstlane((int)threadIdx.x >> 6);
    const bool t0 = (threadIdx.x == 0);
    volatile LAS unsigned* bst = (volatile LAS unsigned*)(lds + 131072 + 1024);
    if (t0) { bst[0] = 0u; bst[1] = 0u; }
    __syncthreads();
    const XcdBarrier gbar = xcd_barrier_post((unsigned*)ap0->ws, bst, t0);
    for (int ph = lo; ph < hi; ++ph) {
        CArgs ap = ap0; asm volatile("" : "+s"(ap));
        const int G = gridDim.x, bx = blockIdx.x;
        const int vcu = (G % 8 == 0) ? (bx % 8) * (G / 8) + bx / 8 : bx;
        const int gw = vcu * NWAVES + wave, NGW = G * NWAVES;
        unsigned char* ws = ap->ws;
        bf16_t* W = (bf16_t*)(ws + WS_W);
        bf16_t* XN = (bf16_t*)(ws + WS_XN);
        if (ph == 0) { PH_ON(256) { for (int rep_ = 0; rep_ < 1 + PROBE_P02; ++rep_) {
            const int lane = lane_op();
            convert_weights(ap, 0, lds, gw, NGW, wave, lane);
            const float* x = ap->in[I_X]; const float* g = ap->in[I_NMPRE];
            for (int m = gw; m < T; m += 4 * NGW) rms_rows4_to_bf16(x + (size_t)m * DM, (size_t)NGW * DM, g, XN + (size_t)m * DM, lane);
            __syncthreads(); } }
        } else {
            const int l = (ph - 1) / NPL, k = (int)((SEQ_PACK >> (4 * ((ph - 1) % NPL))) & 15ull);
            if (k == 0) { PH_ON(1) {
                SchedIn S{XN, W + WO_IN, G, bx};
                EpiIn E{(bf16_t*)(ws + WS_AG), (bf16_t*)(ws + WS_Q), (bf16_t*)(ws + WS_K), (bf16_t*)(ws + WS_GU), (bf16_t*)(ws + WS_GEL), (bf16_t*)(ws + WS_VT), (float*)(ws + WS_STAT)};
                pg8::gemm_phase<EpiIn, SchedIn>(lds, wave, DM, S, E); }
            } else if (k == 1) { PH_ON(2) {
                const int per = (1024 + G - 1) / G;
                PH_ON(512) {
                    const int lane = lane_op();
                    const float la = wave_sum(ap->in[I_LQ1][l * 64 + lane] * ap->in[I_LK1][l * 64 + lane]), lb = wave_sum(ap->in[I_LQ2][l * 64 + lane] * ap->in[I_LK2][l * 64 + lane]);
                    const float lam_init = 0.8f - 0.6f * expf(-0.3f * (float)l);
                    const float lam = __int_as_float(__builtin_amdgcn_readfirstlane(__float_as_int(expf(la) - expf(lb) + lam_init)));
                    const float oscale = __int_as_float(__builtin_amdgcn_readfirstlane(__float_as_int(1.0f - lam_init)));
                    const float* subg = ap->in[I_SUBG] + l * 128;
                    if constexpr (PROBE_ATT2 != 0) { for (int i = 0; i < per; ++i) { const int u = vcu * per + i; if (u < 1024) attn_unit<false>(lds, (bf16_t*)(ws + WS_Q), (const bf16_t*)(ws + WS_K), (const bf16_t*)(ws + WS_VT), subg, lam, oscale, u, wave); } }
                    for (int i = 0; i < per; ++i) { const int u = vcu * per + i; if (u < 1024) attn_unit<true>(lds, (bf16_t*)(ws + WS_Q), (const bf16_t*)(ws + WS_K), (const bf16_t*)(ws + WS_VT), subg, lam, oscale, u, wave); }
                }
                PH_ON(1024) {
                    const float* cw = ap->in[I_CONVW] + (size_t)l * 31 * DM; const float* cb = ap->in[I_CONVB] + l * DM; const float* lg = ap->in[I_CLNG] + l * DM; const float* lb2 = ap->in[I_CLNB] + l * DM;
                    for (int rep_ = 0; rep_ < 1 + PROBE_CONV2; ++rep_) { const int u0 = vcu * per; int nun = 1024 - u0; nun = nun < 0 ? 0 : (nun > per ? per : nun);
                        if ((128 % per) == 0) conv_run(lds, (const bf16_t*)(ws + WS_AG), (bf16_t*)(ws + WS_CA), cw, cb, lg, lb2, u0, nun, wave);
                        else for (int i = 0; i < nun; ++i) conv_run(lds, (const bf16_t*)(ws + WS_AG), (bf16_t*)(ws + WS_CA), cw, cb, lg, lb2, u0 + i, 1, wave); }
                }
                PH_ON(2048) {
                    const float* sw = ap->in[I_SGUW] + (size_t)l * 8 * 16384; const float* sb = ap->in[I_SGUB] + l * 1024; const float* lg = ap->in[I_SLNG] + l * DM; const float* lb2 = ap->in[I_SLNB] + l * DM;
                    if constexpr (PROBE_SGU2 != 0) { for (int i = 0; i < per; ++i) { const int u = vcu * per + i; if (u < 1024) sgu_unit<false>(lds, (const bf16_t*)(ws + WS_GEL), (const float*)(ws + WS_STAT), (bf16_t*)(ws + WS_GU), sw, sb, lg, lb2, u, wave); } }
                    for (int i = 0; i < per; ++i) { const int u = vcu * per + i; if (u < 1024) sgu_unit<true>(lds, (const bf16_t*)(ws + WS_GEL), (const float*)(ws + WS_STAT), (bf16_t*)(ws + WS_GU), sw, sb, lg, lb2, u, wave); }
                } }
            } else if (k == 2) { PH_ON(4) {
                SchedProj S{ws, G, bx};
                EpiProj E{(bf16_t*)(ws + WS_GS), (float*)(ws + WS_SB), (bf16_t*)(ws + WS_MIXPRE), ap->in[I_BGATE] + l * 3072};
                pg8::gemm_phase<EpiProj, SchedProj>(lds, wave, DM, S, E); }
            } else if (k == 3) { PH_ON(8) {
                SchedSimple S{(const bf16_t*)(ws + WS_MIXPRE), W + WO_OUT, 64, 4, DM, G, bx};
#if FUSE_NORM
                float* out = ap->out;
                EpiNormRes E{(l == 0) ? ap->in[I_X] : out, out, ap->in[I_NMPOST] + l * DM, ap->in[I_NFPRE] + l * DM, XN, (float*)(ws + WS_XBUF) + (size_t)(l * 2 + 0) * 2 * T * 4, (unsigned*)(ws + WS_CNT) + (l * 2 + 0) * 2 * 64 * 64, lds};
                pg8::gemm_phase<EpiNormRes, SchedSimple>(lds, wave, DM, S, E);
#else
                EpiF32 E{(float*)(ws + WS_MIX), DM};
                pg8::gemm_phase<EpiF32, SchedSimple>(lds, wave, DM, S, E);
#endif
                }
            } else if (k == 4) { PH_ON(16) {
                const int lane = lane_op();
                float* out = ap->out; const float* xin = (l == 0) ? ap->in[I_X] : out; const float* MIX = (const float*)(ws + WS_MIX);
                const float* gp = ap->in[I_NMPOST] + l * DM; const float* gn = ap->in[I_NFPRE] + l * DM;
                for (int m = gw; m < T; m += NGW) resid_norm_row(MIX + (size_t)m * DM, xin + (size_t)m * DM, out + (size_t)m * DM, gp, gn, XN + (size_t)m * DM, lane); }
            } else if (k == 5) { PH_ON(32) {
                SchedSimple S{XN, W + WO_UP, 64, 16, DM, G, bx};
                EpiRelu2 E{(bf16_t*)(ws + WS_H), DFF};
                pg8::gemm_phase<EpiRelu2, SchedSimple>(lds, wave, DM, S, E); }
            } else if (k == 6) { PH_ON(64) {
                SchedSimple S{(const bf16_t*)(ws + WS_H), W + WO_DOWN, 64, 4, DFF, G, bx};
#if FUSE_NORM
                float* out = ap->out;
                EpiNormRes E{out, out, ap->in[I_NFPOST] + l * DM, (l + 1 < DEPTH) ? ap->in[I_NMPRE] + (l + 1) * DM : nullptr, XN, (float*)(ws + WS_XBUF) + (size_t)(l * 2 + 1) * 2 * T * 4, (unsigned*)(ws + WS_CNT) + (l * 2 + 1) * 2 * 64 * 64, lds};
                pg8::gemm_phase<EpiNormRes, SchedSimple>(lds, wave, DFF, S, E);
#else
                EpiF32 E{(float*)(ws + WS_MIX), DM};
                pg8::gemm_phase<EpiF32, SchedSimple>(lds, wave, DFF, S, E);
#endif
                }
            } else { PH_ON(128) {
                const int lane = lane_op();
                float* out = ap->out; const float* MIX = (const float*)(ws + WS_MIX);
                const float* gp = ap->in[I_NFPOST] + l * DM; const float* gnext = (l + 1 < DEPTH) ? ap->in[I_NMPRE] + (l + 1) * DM : nullptr;
#if !FUSE_NORM
                for (int m = gw; m < T; m += NGW) resid_norm_row(MIX + (size_t)m * DM, out + (size_t)m * DM, out + (size_t)m * DM, gp, gnext, XN + (size_t)m * DM, lane);
#endif
                if (l + 1 < DEPTH) { convert_weights(ap, l + 1, lds, gw, NGW, wave, lane); __syncthreads(); } }
            }
        }
        if (ph + 1 < hi) { if (hi > 4096) cg::this_grid().sync();
            xcd_barrier(gbar, t0); if constexpr (PROBE_SYNC != 0) xcd_barrier(gbar, t0); }
    }
}

extern "C" void kernel_launch(void* const* d_in, const int* in_sizes, int n_in, void* d_out, int out_size, void* d_ws, size_t ws_size, hipStream_t stream) {
    static int grid = 0;
    if (grid == 0) {
        if (n_in != 26 || in_sizes[0] != T * DM || out_size != T * DM || ws_size < WS_END) {
            fprintf(stderr, "kernel_launch: unexpected problem: n_in %d in0 %d out %d ws %zu (need %zu)\n", n_in, n_in > 0 ? in_sizes[0] : -1, out_size, ws_size, (size_t)WS_END); grid = -1; return; }
        int dev = 0, cus = 0, per_cu = 0;
        hipGetDevice(&dev); hipDeviceGetAttribute(&cus, hipDeviceAttributeMultiprocessorCount, dev);
        if (hipFuncSetAttribute((const void*)fwd_megakernel, hipFuncAttributeMaxDynamicSharedMemorySize, LDS_BYTES) != hipSuccess) { fprintf(stderr, "kernel_launch: hipFuncSetAttribute failed\n"); grid = -1; return; }
        if (hipOccupancyMaxActiveBlocksPerMultiprocessor(&per_cu, (const void*)fwd_megakernel, NTHREADS, LDS_BYTES) != hipSuccess || per_cu < 1) { fprintf(stderr, "kernel_launch: occupancy query says %d\n", per_cu); per_cu = 1; }
        (void)hipGetLastError();
        grid = cus * 1;
        if (FUSE_NORM && grid != 256) { fprintf(stderr, "kernel_launch: the fused norm epilogues need a 256-workgroup grid, got %d\n", grid); grid = -1; return; }
        fprintf(stderr, "kernel_launch: grid %d (cus %d, per_cu %d)\n", grid, cus, per_cu);
    }
    if (grid < 0) return;
    if (hipMemsetAsync(d_ws, 0, CTL_BYTES, stream) != hipSuccess) { fprintf(stderr, "kernel_launch: memset failed\n"); return; }
    Args a{};
    for (int i = 0; i < 26; ++i) a.in[i] = (const float*)d_in[i];
    a.out = (float*)d_out; a.ws = (unsigned char*)d_ws;
#if MK_N_LAUNCHES == 1
    a.lo = 0; a.hi = N_PHASES;
    void* args[] = {&a};
    hipError_t e = hipLaunchCooperativeKernel((const void*)fwd_megakernel, dim3(grid), dim3(NTHREADS), args, LDS_BYTES, stream);
    if (e != hipSuccess) fprintf(stderr, "cooperative launch failed: %s (grid %d)\n", hipGetErrorString(e), grid);
#else
    for (int ph = 0; ph < N_PHASES; ++ph) { a.lo = ph; a.hi = ph + 1; hipLaunchKernelGGL(fwd_megakernel, dim3(grid), dim3(NTHREADS), LDS_BYTES, stream, a); }
#endif
}
```

```cpp
#include <hip/hip_runtime.h>
#include <hip/hip_cooperative_groups.h>
#include <cstdio>
#include <cstdint>
namespace cg = cooperative_groups;

#ifndef MK_N_LAUNCHES
#define MK_N_LAUNCHES 1
#endif

#define LAS __attribute__((address_space(3)))
typedef unsigned short bf16_t;
typedef short bf16x8 __attribute__((ext_vector_type(8)));
typedef float f32x4 __attribute__((ext_vector_type(4)));
typedef float f32x2 __attribute__((ext_vector_type(2)));
typedef float f32x16 __attribute__((ext_vector_type(16)));
typedef unsigned u32x4 __attribute__((ext_vector_type(4)));
typedef unsigned u32x2 __attribute__((ext_vector_type(2)));

constexpr int DM = 1024, NB = 8, SEQ = 2048, DEPTH = 2, T = NB * SEQ, DFF = 4096, WIN = 10240;
constexpr float EPS = 1e-6f, LOG2E = 1.4426950408889634f;
constexpr int NTHREADS = 512, NWAVES = 8;

constexpr size_t MiB = 1u << 20;
constexpr size_t WS_W = 1 * MiB;
constexpr size_t WS_XN = 45 * MiB;
constexpr size_t WS_CA = 77 * MiB;
constexpr size_t WS_AG = 109 * MiB;
constexpr size_t WS_K = 141 * MiB;
constexpr size_t WS_VT = 173 * MiB;
constexpr size_t WS_GEL = 205 * MiB;
constexpr size_t WS_Q = 237 * MiB;
constexpr size_t WS_GU = 269 * MiB;
constexpr size_t WS_STAT = 301 * MiB;
constexpr size_t WS_XBUF = 303 * MiB;
constexpr size_t WS_END = 305 * MiB;
constexpr size_t WS_CNT = 16384;
constexpr size_t CTL_BYTES = 16384 + 8 * 64 * 256;
constexpr size_t WS_GS = WS_AG, WS_SB = WS_K, WS_MIXPRE = WS_GEL;
constexpr size_t WS_MIX = WS_AG;
constexpr size_t WS_H = WS_VT;
constexpr size_t WO_IN = 0, WO_PC = (size_t)WIN * DM, WO_PA = WO_PC + (size_t)DM * DM, WO_PS = WO_PA + (size_t)DM * DM,
                 WO_OUT = WO_PS + (size_t)DM * DM, WO_UP = WO_OUT + (size_t)DM * DM, WO_DOWN = WO_UP + (size_t)DFF * DM;

typedef __bf16 bf16x2_t __attribute__((ext_vector_type(2)));
__device__ __forceinline__ unsigned cvt_pk_bf16(float lo, float hi) { const f32x2 v = {lo, hi}; const bf16x2_t b = __builtin_convertvector(v, bf16x2_t); return __builtin_bit_cast(unsigned, b); }
__device__ __forceinline__ float bf_lo(unsigned u) { return __uint_as_float(u << 16); }
__device__ __forceinline__ float bf_hi(unsigned u) { return __uint_as_float(u & 0xffff0000u); }
__device__ __forceinline__ float fast_sigmoid(float x) { return __builtin_amdgcn_rcpf(1.0f + __builtin_amdgcn_exp2f(-x * LOG2E)); }
__device__ __forceinline__ int lane_id() { return (int)__builtin_amdgcn_mbcnt_hi(~0u, __builtin_amdgcn_mbcnt_lo(~0u, 0u)); }
__device__ __forceinline__ int lane_op() { unsigned z = 0u; asm volatile("" : "+v"(z)); return (int)__builtin_amdgcn_mbcnt_hi(~0u, __builtin_amdgcn_mbcnt_lo(~0u, z)); }
__device__ __forceinline__ float wave_sum(float v) {
    int lid = lane_id(); asm volatile("" : "+v"(lid));
#pragma unroll
    for (int o = 1; o < 64; o <<= 1) v += __int_as_float(__builtin_amdgcn_ds_bpermute((lid ^ o) << 2, __float_as_int(v)));
    return v;
}
__device__ __forceinline__ float swap_add(float v) { auto rr = __builtin_amdgcn_permlane32_swap(__float_as_uint(v), __float_as_uint(v), false, false); return __uint_as_float(rr[0]) + __uint_as_float(rr[1]); }
__device__ __forceinline__ float swap_max(float v) { auto rr = __builtin_amdgcn_permlane32_swap(__float_as_uint(v), __float_as_uint(v), false, false); return fmaxf(__uint_as_float(rr[0]), __uint_as_float(rr[1])); }
__device__ __forceinline__ f32x2 gelu_pk(f32x2 v) {
    const f32x2 av = __builtin_elementwise_abs(v), d = av * 0.2316418882f + 1.0f;
    f32x2 t; t.x = __builtin_amdgcn_rcpf(d.x); t.y = __builtin_amdgcn_rcpf(d.y);
    f32x2 q = t * 0.5307027145f + (-0.7265760135f); q = q * t + 0.7107068705f; q = q * t + (-0.142248368f); q = q * t + 0.127414796f; q = q * t;
    const f32x2 s = (v * v) * (-0.72134752044f);
    f32x2 e; e.x = __builtin_amdgcn_exp2f(s.x); e.y = __builtin_amdgcn_exp2f(s.y);
    const f32x2 m = v * (q * e), r = v - m;
    f32x2 o; o.x = v.x < 0.f ? m.x : r.x; o.y = v.y < 0.f ? m.y : r.y; return o;
}
__device__ __forceinline__ f32x4 gelu4(f32x4 v) { f32x2 a = gelu_pk((f32x2){v[0], v[1]}), b = gelu_pk((f32x2){v[2], v[3]}); return (f32x4){a.x, a.y, b.x, b.y}; }

namespace pg8 {
constexpr int BM = 256, BK = 64, HALF = 128, HTB = HALF * BK * 2, STAGE_BYTES = 8 * HTB, NXCD = 8, WGM = 8;
__host__ __device__ __forceinline__ int lds_byte(int r, int c) { const int st = (r >> 4) * 2 + (c >> 5), rr = r & 15, cc = c & 31, ob = rr * 64 + cc * 2; return st * 1024 + (ob ^ (((ob >> 9) & 1) << 5)); }
__host__ __device__ __forceinline__ void stage_rc(int b, int& R, int& C) { const int st = b / 1024, sb = b % 1024, swz = sb ^ (((sb >> 9) & 1) << 5); R = (st >> 1) * 16 + swz / 64; C = (st & 1) * 32 + (swz % 64) / 2; }
__host__ __device__ __forceinline__ int perm32(int rho) { const int n = rho >> 4, i = rho & 15; return 8 * (i >> 2) + 4 * n + (i & 3); }

struct Unit { int pm, pn, j; };
__device__ __forceinline__ void tile_map(int wgid, int nM, int nN, int& pm, int& pn) {
    const int nwg = nM * nN;
    { const int q = nwg / NXCD, r = nwg % NXCD, xcd = wgid % NXCD, off = wgid / NXCD; wgid = (xcd < r ? xcd * (q + 1) : r * (q + 1) + (xcd - r) * q) + off; }
    const int nig = WGM * nN, gid = wgid / nig, fm = gid * WGM, gsz = (nM - fm) < WGM ? (nM - fm) : WGM;
    pm = fm + ((wgid % nig) % gsz); pn = (wgid % nig) / gsz;
}

template <class Epi, class Sched, bool ALIGN_EPI = true>
__device__ __forceinline__ void gemm_phase(LAS unsigned char* lds, const int wave_s, const int K, const Sched& S, const Epi& E) {
    const int tid_ = wave_s * 64 + lane_op();
    const int tid = tid_, wid = wave_s, lane = tid & 63, wr = wid >> 2, wc = wid & 3, fr = lane & 15, fq = lane >> 4;
    const int nt = K / BK;
    unsigned voffA[2], voffB[2];
#pragma unroll
    for (int i = 0; i < 2; ++i) { int R, C; stage_rc(tid * 16 + i * 8192, R, C); const int Rb = (R & ~31) + perm32(R & 31);
        voffA[i] = (unsigned)(R * K + C) * 2u; voffB[i] = (unsigned)(Rb * K + C) * 2u; }
    const size_t kstep = (size_t)(BK * 2);
    const size_t hstep = (size_t)HALF * K * 2;
    const unsigned ldsw = (unsigned)wid * 1024u;
    const int aoff = lds_byte(wr * 64 + fr, fq * 8), boff = lds_byte(wc * 32 + fr, fq * 8);
#define PG8_SA(b, h) (((b) * 2 + (h)) * HTB)
#define PG8_SB(b, h) ((4 + (b) * 2 + (h)) * HTB)
#define PG8_STAGE(bufoff, gbase, voff) do { _Pragma("unroll") for (int _i = 0; _i < 2; ++_i) \
        __builtin_amdgcn_global_load_lds((const unsigned*)((const char*)(gbase) + (voff)[_i]), (LAS unsigned*)(lds + (bufoff) + ldsw + _i * 8192), 16, 0, 0); } while (0)
#define PG8_LDA(dst, b, h) do { _Pragma("unroll") for (int m = 0; m < 4; ++m) _Pragma("unroll") for (int k = 0; k < 2; ++k) dst[m][k] = *(const LAS bf16x8*)(lds + PG8_SA(b, h) + aoff + m * 2048 + k * 1024); } while (0)
#define PG8_LDB(dst, b, h) do { _Pragma("unroll") for (int n = 0; n < 2; ++n) _Pragma("unroll") for (int k = 0; k < 2; ++k) dst[n][k] = *(const LAS bf16x8*)(lds + PG8_SB(b, h) + boff + n * 2048 + k * 1024); } while (0)
#define PG8_MMA(ai, bj, At, Bt) do { __builtin_amdgcn_s_setprio(1); _Pragma("unroll") for (int m = 0; m < 4; ++m) _Pragma("unroll") for (int n = 0; n < 2; ++n) _Pragma("unroll") for (int k = 0; k < 2; ++k) \
        acc[ai][bj][m][n] = __builtin_amdgcn_mfma_f32_16x16x32_bf16(Bt[n][k], At[m][k], acc[ai][bj][m][n], 0, 0, 0); __builtin_amdgcn_s_setprio(0); } while (0)
#define PG8_WAIT_V(n) asm volatile("s_waitcnt vmcnt(" #n ")" ::: "memory")
#define PG8_WAIT_L(n) asm volatile("s_waitcnt lgkmcnt(" #n ")" ::: "memory")
#define PG8_BAR __builtin_amdgcn_s_barrier()
#define PG8_SCHED __builtin_amdgcn_sched_barrier(0)
    Unit cur, nxt; int ui = 0;
    if (!S.next(0, cur)) return;
    f32x4 acc[2][2][4][2];
#pragma unroll
    for (int a = 0; a < 2; ++a)
#pragma unroll
        for (int b = 0; b < 2; ++b)
#pragma unroll
            for (int m = 0; m < 4; ++m)
#pragma unroll
                for (int n = 0; n < 2; ++n) acc[a][b][m][n] = (f32x4){0.f, 0.f, 0.f, 0.f};
    bf16x8 At[4][2], B0[2][2], B1[2][2];
    const char* cA = S.aptr(cur); const char* cB = S.bptr(cur);
    PG8_STAGE(PG8_SB(0, 0), cB, voffB); PG8_STAGE(PG8_SB(0, 1), cB + hstep, voffB); PG8_STAGE(PG8_SA(0, 0), cA, voffA); PG8_STAGE(PG8_SA(0, 1), cA + hstep, voffA);
    if (wr == 1) PG8_BAR;
    PG8_WAIT_V(2); PG8_BAR;
    PG8_STAGE(PG8_SB(1, 0), cB + kstep, voffB); PG8_STAGE(PG8_SA(1, 0), cA + kstep, voffA); PG8_STAGE(PG8_SB(1, 1), cB + hstep + kstep, voffB);
    PG8_WAIT_V(6); PG8_BAR;
    for (;;) {
        const bool has_next = S.next(ui + 1, nxt);
        const char* nA = has_next ? S.aptr(nxt) : cA; const char* nB = has_next ? S.bptr(nxt) : cB;
        for (int t = 0; t < nt; t += 2) {
            const bool last = (t == nt - 2);
            const char* a1 = cA + (size_t)(t + 1) * kstep;
            const char* a2 = last ? nA : cA + (size_t)(t + 2) * kstep; const char* b2 = last ? nB : cB + (size_t)(t + 2) * kstep;
            const char* a3 = a2 + kstep; const char* b3 = b2 + kstep;
            PG8_LDB(B0, 0, 0); PG8_LDB(B1, 0, 1); PG8_SCHED; PG8_LDA(At, 0, 0); PG8_STAGE(PG8_SA(1, 1), a1 + hstep, voffA);
            PG8_WAIT_V(8); PG8_WAIT_L(0); PG8_BAR; PG8_MMA(0, 0, At, B0); PG8_MMA(0, 1, At, B1); PG8_BAR; PG8_SCHED;
            PG8_LDA(At, 0, 1); PG8_STAGE(PG8_SB(0, 0), b2, voffB); PG8_STAGE(PG8_SB(0, 1), b2 + hstep, voffB); PG8_STAGE(PG8_SA(0, 0), a2, voffA);
            PG8_WAIT_V(8); PG8_WAIT_L(0); PG8_BAR; PG8_MMA(1, 0, At, B0); PG8_MMA(1, 1, At, B1); PG8_BAR; PG8_SCHED;
            PG8_LDB(B0, 1, 0); PG8_LDB(B1, 1, 1); PG8_SCHED; PG8_LDA(At, 1, 0); PG8_STAGE(PG8_SA(0, 1), a2 + hstep, voffA);
            PG8_WAIT_V(8); PG8_WAIT_L(0); PG8_BAR; PG8_MMA(0, 0, At, B0); PG8_MMA(0, 1, At, B1); PG8_BAR; PG8_SCHED;
            PG8_LDA(At, 1, 1); PG8_STAGE(PG8_SB(1, 0), b3, voffB); PG8_STAGE(PG8_SB(1, 1), b3 + hstep, voffB); PG8_STAGE(PG8_SA(1, 0), a3, voffA);
            PG8_WAIT_V(8); PG8_WAIT_L(0); PG8_BAR; PG8_MMA(1, 0, At, B0); PG8_MMA(1, 1, At, B1); PG8_BAR; PG8_SCHED;
        }
        if constexpr (ALIGN_EPI) { if (wr == 0) PG8_BAR; }
        E(acc, cur, wr, wc, fr, fq);
        if (!has_next) break;
#pragma unroll
        for (int a = 0; a < 2; ++a)
#pragma unroll
            for (int b = 0; b < 2; ++b)
#pragma unroll
                for (int m = 0; m < 4; ++m)
#pragma unroll
                    for (int n = 0; n < 2; ++n) acc[a][b][m][n] = (f32x4){0.f, 0.f, 0.f, 0.f};
        cur = nxt; cA = nA; cB = nB; ++ui;
        if constexpr (ALIGN_EPI) { if (wr == 1) PG8_BAR; }
    }
    PG8_WAIT_V(0);
    if constexpr (!ALIGN_EPI) { if (wr == 0) PG8_BAR; }
    PG8_BAR;
#undef PG8_SA
#undef PG8_SB
#undef PG8_STAGE
#undef PG8_LDA
#undef PG8_LDB
#undef PG8_MMA
#undef PG8_WAIT_V
#undef PG8_WAIT_L
#undef PG8_BAR
#undef PG8_SCHED
}
}
using pg8::Unit;

struct SchedSimple {
    const bf16_t* A; const bf16_t* Bt; int nM, nN, K, G, c;
    __device__ __forceinline__ bool next(int i, Unit& u) const { const long L = (long)i * G + c; if (L >= (long)nM * nN) return false; pg8::tile_map((int)L, nM, nN, u.pm, u.pn); u.j = 0; return true; }
    __device__ __forceinline__ const char* aptr(const Unit& u) const { return (const char*)A + (size_t)u.pm * 256 * K * 2; }
    __device__ __forceinline__ const char* bptr(const Unit& u) const { return (const char*)Bt + (size_t)u.pn * 256 * K * 2; }
};
struct SchedIn {
    const bf16_t* XN; const bf16_t* W; int G, c;
    __device__ __forceinline__ bool next(int i, Unit& u) const {
        const int L = i * G + c;
        if (L < 64 * 24) { pg8::tile_map(L, 64, 24, u.pm, u.pn); u.j = 0; return true; }
        const int L1 = L - 64 * 24; if (L1 >= 4 * 64) return false;
        pg8::tile_map(L1, 4, 64, u.pm, u.pn); u.j = 1; return true;
    }
    __device__ __forceinline__ const char* aptr(const Unit& u) const { return u.j == 0 ? (const char*)XN + (size_t)u.pm * 256 * DM * 2 : (const char*)W + (size_t)(6144 + u.pm * 256) * DM * 2; }
    __device__ __forceinline__ const char* bptr(const Unit& u) const { return u.j == 0 ? (const char*)W + (size_t)u.pn * 256 * DM * 2 : (const char*)XN + (size_t)u.pn * 256 * DM * 2; }
};
struct SchedProj {
    const unsigned char* ws; int G, c;
    __device__ __forceinline__ bool next(int i, Unit& u) const { const int L = (i / 6) * G + c; if (L >= 256) return false; pg8::tile_map(L, 64, 4, u.pm, u.pn); u.j = i % 6; return true; }
    __device__ __forceinline__ const char* aptr(const Unit& u) const { const int br = u.j >> 1;
        const size_t off = (u.j & 1) ? (br == 0 ? WS_CA : br == 1 ? WS_Q : WS_GU) : WS_XN; return (const char*)ws + off + (size_t)u.pm * 256 * DM * 2; }
    __device__ __forceinline__ const char* bptr(const Unit& u) const { const int br = u.j >> 1;
        const size_t off = (u.j & 1) ? (WS_W + 2 * (WO_PC + (size_t)br * DM * DM)) : (WS_W + 2 * (WO_IN + (size_t)(7168 + br * 1024) * DM)); return (const char*)ws + off + (size_t)u.pn * 256 * DM * 2; }
};

constexpr float QSCALE = 0.125f * LOG2E;
struct EpiIn {
    bf16_t *AG, *Q, *Kb, *GU, *GEL, *VT; float* STAT;
    __device__ __forceinline__ void operator()(const f32x4 (&acc)[2][2][4][2], const Unit& u, int wr, int wc, int fr, int fq) const {
        const int row0 = u.pm * 256 + wr * 64 + fr;
        if (u.j == 1) {
#pragma unroll
            for (int ai = 0; ai < 2; ++ai)
#pragma unroll
                for (int m = 0; m < 4; ++m) { bf16_t* rowp = VT + (size_t)(row0 + ai * 128 + m * 16) * T + u.pn * 256 + wc * 32 + 16 * (fq >> 1);
#pragma unroll
                    for (int bj = 0; bj < 2; ++bj)
#pragma unroll
                        for (int n = 0; n < 2; ++n) { const f32x4 v = acc[ai][bj][m][n]; u32x2 w; w.x = cvt_pk_bf16(v[0], v[1]); w.y = cvt_pk_bf16(v[2], v[3]);
                            *(u32x2*)(rowp + bj * 128 + 4 * (2 * n + (fq & 1))) = w; } }
            return;
        }
        const int pn = u.pn;
        if (pn < 8) {
            const int col = pn * 128 + wc * 32 + 8 * fq;
#pragma unroll
            for (int ai = 0; ai < 2; ++ai)
#pragma unroll
                for (int m = 0; m < 4; ++m) { f32x4 v0 = acc[ai][0][m][0], v1 = acc[ai][0][m][1]; const f32x4 g0 = acc[ai][1][m][0], g1 = acc[ai][1][m][1];
#pragma unroll
                    for (int i = 0; i < 4; ++i) { v0[i] *= fast_sigmoid(g0[i]); v1[i] *= fast_sigmoid(g1[i]); }
                    u32x4 w; w.x = cvt_pk_bf16(v0[0], v0[1]); w.y = cvt_pk_bf16(v0[2], v0[3]); w.z = cvt_pk_bf16(v1[0], v1[1]); w.w = cvt_pk_bf16(v1[2], v1[3]);
                    *(u32x4*)(AG + (size_t)(row0 + ai * 128 + m * 16) * DM + col) = w; }
            return;
        }
        const int sec = (pn - 8) >> 2;
        bf16_t* base = sec == 0 ? Q : sec == 1 ? Kb : sec == 2 ? GU : GEL;
        const int col = ((pn - 8) & 3) * 256 + wc * 32 + 8 * fq;
        const float sc = sec == 0 ? QSCALE : 1.0f;
#pragma unroll
        for (int ai = 0; ai < 2; ++ai)
#pragma unroll
            for (int m = 0; m < 4; ++m) { bf16_t* rowp = base + (size_t)(row0 + ai * 128 + m * 16) * DM + col; float ps = 0.f, ps2 = 0.f;
#pragma unroll
                for (int bj = 0; bj < 2; ++bj) { f32x4 v0 = acc[ai][bj][m][0], v1 = acc[ai][bj][m][1];
                    if (sec >= 2) { v0 = gelu4(v0); v1 = gelu4(v1); }
                    v0 = v0 * sc; v1 = v1 * sc;
                    if (sec == 3) { ps += (v0[0] + v0[1]) + (v0[2] + v0[3]) + (v1[0] + v1[1]) + (v1[2] + v1[3]);
                        ps2 += (v0[0] * v0[0] + v0[1] * v0[1]) + (v0[2] * v0[2] + v0[3] * v0[3]) + (v1[0] * v1[0] + v1[1] * v1[1]) + (v1[2] * v1[2] + v1[3] * v1[3]); }
                    u32x4 w; w.x = cvt_pk_bf16(v0[0], v0[1]); w.y = cvt_pk_bf16(v0[2], v0[3]); w.z = cvt_pk_bf16(v1[0], v1[1]); w.w = cvt_pk_bf16(v1[2], v1[3]);
                    *(u32x4*)(rowp + bj * 128) = w; }
                if (sec == 3) {
                    const int lid = (fq << 4) | fr;
                    ps += __int_as_float(__builtin_amdgcn_ds_bpermute((lid ^ 16) << 2, __float_as_int(ps))); ps2 += __int_as_float(__builtin_amdgcn_ds_bpermute((lid ^ 16) << 2, __float_as_int(ps2)));
                    ps = swap_add(ps); ps2 = swap_add(ps2);
                    if (fq == 0) *(f32x2*)(STAT + (size_t)(row0 + ai * 128 + m * 16) * 32 + (((pn - 8) & 3) * 4 + wc) * 2) = (f32x2){ps, ps2}; } }
    }
};
struct EpiProj {
    bf16_t* Gs; float* Sb; bf16_t* MIXPRE; const float* bgate;
    __device__ __forceinline__ void operator()(const f32x4 (&acc)[2][2][4][2], const Unit& u, int wr, int wc, int fr, int fq) const {
        const int tile = u.pm * 4 + u.pn, tid = (wr * 4 + wc) * 64 + fq * 16 + fr, br = u.j >> 1;
        const int row0 = u.pm * 256 + wr * 64 + fr, col00 = u.pn * 256 + wc * 32 + 8 * fq;
        if ((u.j & 1) == 0) {
#pragma unroll
            for (int bj = 0; bj < 2; ++bj) { const f32x4 b0 = *(const f32x4*)(bgate + br * 1024 + col00 + bj * 128), b1 = *(const f32x4*)(bgate + br * 1024 + col00 + bj * 128 + 4);
#pragma unroll
                for (int ai = 0; ai < 2; ++ai)
#pragma unroll
                    for (int m = 0; m < 4; ++m) { f32x4 v0 = acc[ai][bj][m][0] + b0, v1 = acc[ai][bj][m][1] + b1;
#pragma unroll
                        for (int i = 0; i < 4; ++i) { v0[i] = fast_sigmoid(v0[i]); v1[i] = fast_sigmoid(v1[i]); }
                        u32x4 w; w.x = cvt_pk_bf16(v0[0], v0[1]); w.y = cvt_pk_bf16(v0[2], v0[3]); w.z = cvt_pk_bf16(v1[0], v1[1]); w.w = cvt_pk_bf16(v1[2], v1[3]);
                        *((u32x4*)Gs + ((size_t)(tile * 16 + (ai * 2 + bj) * 4 + m) * NTHREADS + tid)) = w; } }
            return;
        }
#pragma unroll
        for (int ai = 0; ai < 2; ++ai)
#pragma unroll
            for (int bj = 0; bj < 2; ++bj)
#pragma unroll
                for (int m = 0; m < 4; ++m) {
                    const u32x4 g = *((const u32x4*)Gs + ((size_t)(tile * 16 + (ai * 2 + bj) * 4 + m) * NTHREADS + tid));
                    f32x4 y0 = acc[ai][bj][m][0], y1 = acc[ai][bj][m][1];
                    y0[0] *= bf_lo(g.x); y0[1] *= bf_hi(g.x); y0[2] *= bf_lo(g.y); y0[3] *= bf_hi(g.y);
                    y1[0] *= bf_lo(g.z); y1[1] *= bf_hi(g.z); y1[2] *= bf_lo(g.w); y1[3] *= bf_hi(g.w);
                    u32x4* sp = (u32x4*)Sb + ((size_t)(tile * 16 + (ai * 2 + bj) * 4 + m) * NTHREADS + tid);
                    if (br != 0) { const u32x4 t = *sp;
                        y0[0] += bf_lo(t.x); y0[1] += bf_hi(t.x); y0[2] += bf_lo(t.y); y0[3] += bf_hi(t.y); y1[0] += bf_lo(t.z); y1[1] += bf_hi(t.z); y1[2] += bf_lo(t.w); y1[3] += bf_hi(t.w); }
                    u32x4 w; w.x = cvt_pk_bf16(y0[0], y0[1]); w.y = cvt_pk_bf16(y0[2], y0[3]); w.z = cvt_pk_bf16(y1[0], y1[1]); w.w = cvt_pk_bf16(y1[2], y1[3]);
                    if (br != 2) *sp = w;
                    else {
                        *(u32x4*)(MIXPRE + (size_t)(row0 + ai * 128 + m * 16) * DM + col00 + bj * 128) = w; }
                }
    }
};
struct EpiF32 {
    float* O; int ldc;
    __device__ __forceinline__ void operator()(const f32x4 (&acc)[2][2][4][2], const Unit& u, int wr, int wc, int fr, int fq) const {
        const int row0 = u.pm * 256 + wr * 64 + fr, col0 = u.pn * 256 + wc * 32 + 8 * fq;
#pragma unroll
        for (int ai = 0; ai < 2; ++ai)
#pragma unroll
            for (int m = 0; m < 4; ++m) { float* rowp = O + (size_t)(row0 + ai * 128 + m * 16) * ldc + col0;
#pragma unroll
                for (int bj = 0; bj < 2; ++bj) { *(f32x4*)(rowp + bj * 128) = acc[ai][bj][m][0]; *(f32x4*)(rowp + bj * 128 + 4) = acc[ai][bj][m][1]; } }
    }
};
struct EpiRelu2 {
    bf16_t* O; int ldc;
    __device__ __forceinline__ void operator()(const f32x4 (&acc)[2][2][4][2], const Unit& u, int wr, int wc, int fr, int fq) const {
        const int row0 = u.pm * 256 + wr * 64 + fr, col0 = u.pn * 256 + wc * 32 + 8 * fq;
#pragma unroll
        for (int ai = 0; ai < 2; ++ai)
#pragma unroll
            for (int m = 0; m < 4; ++m) { bf16_t* rowp = O + (size_t)(row0 + ai * 128 + m * 16) * ldc + col0;
#pragma unroll
                for (int bj = 0; bj < 2; ++bj) { f32x4 v0 = acc[ai][bj][m][0], v1 = acc[ai][bj][m][1];
#pragma unroll
                    for (int i = 0; i < 4; ++i) { const float a = fmaxf(v0[i], 0.f), b = fmaxf(v1[i], 0.f); v0[i] = a * a; v1[i] = b * b; }
                    u32x4 w; w.x = cvt_pk_bf16(v0[0], v0[1]); w.y = cvt_pk_bf16(v0[2], v0[3]); w.z = cvt_pk_bf16(v1[0], v1[1]); w.w = cvt_pk_bf16(v1[2], v1[3]);
                    *(u32x4*)(rowp + bj * 128) = w; } }
    }
};


constexpr int EN_P = 135168, EN_S = EN_P + 4096, EN_F = EN_S + 1024;
struct EpiNormRes {
    const float* xin; float* xout; const float* gpost; const float* gnext; bf16_t* XN; float* xbuf; unsigned* cnt; LAS unsigned char* lds;
    __device__ __forceinline__ void exchange(const f32x4 (&acc)[2][2][4][2], const Unit& u, int e, int wr, int wc, int fr, int fq) const {
        LAS float* P = (LAS float*)(lds + EN_P); LAS float* S = (LAS float*)(lds + EN_S); volatile LAS unsigned* FL = (volatile LAS unsigned*)(lds + EN_F);
        const int lid = (fq << 4) | fr, wid = wr * 4 + wc, tid = wid * 64 + lid;
#pragma unroll
        for (int ai = 0; ai < 2; ++ai)
#pragma unroll
            for (int m = 0; m < 4; ++m) { float q = 0.f;
#pragma unroll
                for (int bj = 0; bj < 2; ++bj)
#pragma unroll
                    for (int n = 0; n < 2; ++n) { const f32x4 v = acc[ai][bj][m][n]; q += (v[0] * v[0] + v[1] * v[1]) + (v[2] * v[2] + v[3] * v[3]); }
                q += __int_as_float(__builtin_amdgcn_ds_bpermute((lid ^ 16) << 2, __float_as_int(q))); q = swap_add(q);
                if (fq == 0) P[(ai * 128 + wr * 64 + m * 16 + fr) * 4 + wc] = q; }
        __syncthreads();
        float* xb = xbuf + (size_t)e * T * 4 + (size_t)u.pm * 256 * 4; unsigned* c = cnt + (e * 64 + u.pm) * 64;
        if (tid < 256) { const float tot = (P[tid * 4] + P[tid * 4 + 1]) + (P[tid * 4 + 2] + P[tid * 4 + 3]);
            __hip_atomic_store(xb + tid * 4 + u.pn, tot, __ATOMIC_RELAXED, __HIP_MEMORY_SCOPE_AGENT); }
        asm volatile("s_waitcnt vmcnt(0)" ::: "memory");
        if (tid < 256 && lid == 0) __hip_atomic_fetch_add(c, 1u, __ATOMIC_RELAXED, __HIP_MEMORY_SCOPE_AGENT);
        if (wid == 0) { unsigned sp = 0;
            while ((unsigned)__builtin_amdgcn_readfirstlane((int)__hip_atomic_load(c, __ATOMIC_RELAXED, __HIP_MEMORY_SCOPE_AGENT)) < 16u) { __builtin_amdgcn_s_sleep(2); if (++sp > (1u << 22)) break; }
            __builtin_amdgcn_fence(__ATOMIC_ACQUIRE, "agent");
            if (lid == 0) FL[0] = 1u; }
        asm volatile("s_waitcnt vmcnt(0) lgkmcnt(0)" ::: "memory");
        __syncthreads();
        if (tid < 256) { float t4 = 0.f;
#pragma unroll
            for (int k = 0; k < 4; ++k) t4 += __hip_atomic_load(xb + tid * 4 + k, __ATOMIC_RELAXED, __HIP_MEMORY_SCOPE_AGENT);
            S[tid] = 1.0f / sqrtf(t4 * (1.f / DM) + EPS); }
        __syncthreads();
    }
    __device__ __forceinline__ void operator()(f32x4 (&acc)[2][2][4][2], const Unit& u, int wr, int wc, int fr, int fq) const {
        const LAS float* S = (const LAS float*)(lds + EN_S);
        const int col0 = u.pn * 256 + wc * 32 + 8 * fq;
        exchange(acc, u, 0, wr, wc, fr, fq);
#pragma unroll
        for (int ai = 0; ai < 2; ++ai)
#pragma unroll
            for (int m = 0; m < 4; ++m) { const int rl = ai * 128 + wr * 64 + m * 16 + fr; const float r1 = S[rl]; const size_t off = (size_t)(u.pm * 256 + rl) * DM + col0;
#pragma unroll
                for (int bj = 0; bj < 2; ++bj) { const f32x4 xa = *(const f32x4*)(xin + off + bj * 128), xb = *(const f32x4*)(xin + off + bj * 128 + 4);
                    const f32x4 ga = *(const f32x4*)(gpost + col0 + bj * 128), gb = *(const f32x4*)(gpost + col0 + bj * 128 + 4);
                    const f32x4 v0 = xa + acc[ai][bj][m][0] * r1 * ga, v1 = xb + acc[ai][bj][m][1] * r1 * gb;
                    *(f32x4*)(xout + off + bj * 128) = v0; *(f32x4*)(xout + off + bj * 128 + 4) = v1; acc[ai][bj][m][0] = v0; acc[ai][bj][m][1] = v1; }
                asm volatile("" ::: "memory"); }
        if (gnext) {
            exchange(acc, u, 1, wr, wc, fr, fq);
#pragma unroll
            for (int ai = 0; ai < 2; ++ai)
#pragma unroll
                for (int m = 0; m < 4; ++m) { const int rl = ai * 128 + wr * 64 + m * 16 + fr; const float r2 = S[rl]; const size_t off = (size_t)(u.pm * 256 + rl) * DM + col0;
#pragma unroll
                    for (int bj = 0; bj < 2; ++bj) { const f32x4 ga = *(const f32x4*)(gnext + col0 + bj * 128), gb = *(const f32x4*)(gnext + col0 + bj * 128 + 4);
                        const f32x4 v0 = acc[ai][bj][m][0] * r2 * ga, v1 = acc[ai][bj][m][1] * r2 * gb;
                        u32x4 w; w.x = cvt_pk_bf16(v0[0], v0[1]); w.y = cvt_pk_bf16(v0[2], v0[3]); w.z = cvt_pk_bf16(v1[0], v1[1]); w.w = cvt_pk_bf16(v1[2], v1[3]);
                        *(u32x4*)(XN + off + bj * 128) = w; }
                    asm volatile("" ::: "memory"); }
        }
    }
};

struct Args { const float* in[26]; float* out; unsigned char* ws; int lo, hi; };
enum { I_X = 0, I_NMPRE, I_NMPOST, I_WIN, I_BGATE, I_CONVW, I_CONVB, I_CLNG, I_CLNB, I_LQ1, I_LK1, I_LQ2, I_LK2, I_SUBG, I_SLNG, I_SLNB, I_SGUW, I_SGUB,
       I_WPC, I_WPA, I_WPS, I_WOUT, I_NFPRE, I_NFPOST, I_WUP, I_WDOWN };

__device__ __forceinline__ void transpose_item(const float* W, int ld, int scol, bf16_t* WT, int K, int drow, int k0, LAS float* scr, int lane) {
    float tv[32];
#pragma unroll
    for (int i = 0; i < 32; ++i) tv[i] = W[(size_t)(k0 + 2 * i + (lane >> 5)) * ld + scol + (lane & 31)];
#pragma unroll
    for (int i = 0; i < 32; ++i) scr[(2 * i + (lane >> 5)) * 33 + (lane & 31)] = tv[i];
    asm volatile("s_waitcnt lgkmcnt(0)" ::: "memory");
    const int c = lane & 7;
#pragma unroll
    for (int j = 0; j < 4; ++j) { const int n = (lane >> 3) + 8 * j; const LAS float* s = scr + (8 * c) * 33 + n;
        u32x4 o; o.x = cvt_pk_bf16(s[0 * 33], s[1 * 33]); o.y = cvt_pk_bf16(s[2 * 33], s[3 * 33]); o.z = cvt_pk_bf16(s[4 * 33], s[5 * 33]); o.w = cvt_pk_bf16(s[6 * 33], s[7 * 33]);
        *(u32x4*)(WT + (size_t)(drow + n) * K + k0 + 8 * c) = o; }
    asm volatile("s_waitcnt lgkmcnt(0)" ::: "memory");
}
__device__ __forceinline__ int win_src_col(int rb) {
    if (rb < 16) return (rb & 1) * 1024 + 128 * (rb >> 1);
    if (rb < 32) return rb * 128;
    if (rb < 48) return rb * 128 + 1024;
    if (rb < 56) return 4096 + (rb - 48) * 128;
    return rb * 128;
}
typedef const __attribute__((address_space(4))) Args* CArgsW;
__device__ __forceinline__ void convert_weights(CArgsW a, int layer, LAS unsigned char* lds, int gw, int NGW, int wave, int lane) {
    LAS float* scr = (LAS float*)(lds + wave * 16384);
    bf16_t* W = (bf16_t*)(a->ws + WS_W);
    constexpr int I_IN = 16 * 320, I_SQ = 16 * 32, I_U = 16 * 128, I_D = 64 * 32, NIT = I_IN + 4 * I_SQ + I_U + I_D;
    for (int it = gw; it < NIT; it += NGW) {
        int r = it;
        if (r < I_IN) { const int kb = r / 320, nb = r % 320; transpose_item(a->in[I_WIN] + (size_t)layer * DM * WIN, WIN, win_src_col(nb >> 2) + (nb & 3) * 32, W + WO_IN, DM, nb * 32, kb * 64, scr, lane); continue; }
        r -= I_IN;
        if (r < 4 * I_SQ) { const int w = r / I_SQ, q = r % I_SQ, kb = q / 32, nb = q % 32;
            const float* src = a->in[w == 0 ? I_WPC : w == 1 ? I_WPA : w == 2 ? I_WPS : I_WOUT] + (size_t)layer * DM * DM;
            transpose_item(src, DM, nb * 32, W + WO_PC + (size_t)w * DM * DM, DM, nb * 32, kb * 64, scr, lane); continue; }
        r -= 4 * I_SQ;
        if (r < I_U) { const int kb = r / 128, nb = r % 128; transpose_item(a->in[I_WUP] + (size_t)layer * DM * DFF, DFF, nb * 32, W + WO_UP, DM, nb * 32, kb * 64, scr, lane); continue; }
        r -= I_U;
        { const int kb = r / 32, nb = r % 32; transpose_item(a->in[I_WDOWN] + (size_t)layer * DFF * DM, DM, nb * 32, W + WO_DOWN, DFF, nb * 32, kb * 64, scr, lane); }
    }
}

__device__ __forceinline__ void rms_rows4_to_bf16(const float* x0row, size_t rstride, const float* g, bf16_t* o0row, int lane) {
    f32x4 v[4][4]; float s[4];
#pragma unroll
    for (int r = 0; r < 4; ++r) { const f32x4* xr = (const f32x4*)(x0row + r * rstride) + lane; s[r] = 0.f;
#pragma unroll
        for (int j = 0; j < 4; ++j) v[r][j] = xr[64 * j]; }
#pragma unroll
    for (int r = 0; r < 4; ++r)
#pragma unroll
        for (int j = 0; j < 4; ++j) s[r] += (v[r][j].x * v[r][j].x + v[r][j].y * v[r][j].y) + (v[r][j].z * v[r][j].z + v[r][j].w * v[r][j].w);
    { int lid = lane_id(); asm volatile("" : "+v"(lid));
#pragma unroll
      for (int o = 1; o < 64; o <<= 1)
#pragma unroll
          for (int r = 0; r < 4; ++r) s[r] += __int_as_float(__builtin_amdgcn_ds_bpermute((lid ^ o) << 2, __float_as_int(s[r]))); }
    const f32x4* gr = (const f32x4*)g + lane;
#pragma unroll
    for (int r = 0; r < 4; ++r) { const float rstd = __builtin_amdgcn_rsqf(s[r] * (1.f / DM) + EPS); u32x2* o8 = (u32x2*)(o0row + r * rstride) + lane;
#pragma unroll
        for (int j = 0; j < 4; ++j) { const f32x4 gg = gr[64 * j]; u32x2 w; w.x = cvt_pk_bf16(v[r][j].x * rstd * gg.x, v[r][j].y * rstd * gg.y); w.y = cvt_pk_bf16(v[r][j].z * rstd * gg.z, v[r][j].w * rstd * gg.w); o8[64 * j] = w; } }
}
__device__ __forceinline__ void resid_norm_row(const float* yrow, const float* xin, float* xout, const float* gpost, const float* gnext, bf16_t* xn, int lane) {
    const f32x4* yr = (const f32x4*)yrow + lane; const f32x4* xr = (const f32x4*)xin + lane; const f32x4* gp = (const f32x4*)gpost + lane;
    f32x4 v[4]; float s = 0.f;
#pragma unroll
    for (int j = 0; j < 4; ++j) { v[j] = yr[64 * j]; s += (v[j].x * v[j].x + v[j].y * v[j].y) + (v[j].z * v[j].z + v[j].w * v[j].w); }
    const float rstd = 1.f / sqrtf(wave_sum(s) * (1.f / DM) + EPS);
    float s2 = 0.f;
#pragma unroll
    for (int j = 0; j < 4; ++j) { const f32x4 xx = xr[64 * j], gg = gp[64 * j]; v[j] = xx + v[j] * rstd * gg; s2 += (v[j].x * v[j].x + v[j].y * v[j].y) + (v[j].z * v[j].z + v[j].w * v[j].w); }
    f32x4* xo = (f32x4*)xout + lane;
#pragma unroll
    for (int j = 0; j < 4; ++j) xo[64 * j] = v[j];
    if (gnext) {
        const float r2 = 1.f / sqrtf(wave_sum(s2) * (1.f / DM) + EPS);
        const f32x4* gn = (const f32x4*)gnext + lane; u32x2* o8 = (u32x2*)xn + lane;
#pragma unroll
        for (int j = 0; j < 4; ++j) { const f32x4 gg = gn[64 * j]; u32x2 w; w.x = cvt_pk_bf16(v[j].x * r2 * gg.x, v[j].y * r2 * gg.y); w.y = cvt_pk_bf16(v[j].z * r2 * gg.z, v[j].w * r2 * gg.w); o8[64 * j] = w; }
    }
}

__device__ __forceinline__ void conv_run(LAS unsigned char* lds, const bf16_t* AG, bf16_t* CA, const float* cw, const float* cb, const float* lng, const float* lnb, int unit0, int nun, const int wave_s) {
    const int tid_ = wave_s * 64 + lane_op();
    const int tid = tid_, lane = tid & 63, wid = wave_s;
    const int c = 2 * tid;
    f32x2 in[46]; unsigned nx[16];
    LAS float* red = (LAS float*)lds;
    LAS float* stat = (LAS float*)(lds + 65536);
    const f32x2 bias = *(const f32x2*)(cb + c);
    const f32x2 g = *(const f32x2*)(lng + c), bb = *(const f32x2*)(lnb + c);
    LAS unsigned* wl = (LAS unsigned*)(lds + 65536 + 256);
#pragma unroll
    for (int j = 0; j < 31; ++j) { const f32x2 w = *(const f32x2*)(cw + j * DM + c); wl[j * 512 + tid] = cvt_pk_bf16(w.x, w.y); }
    for (int u = 0; u < nun; ++u) {
        const int tok0 = (unit0 + u) * 16, b = tok0 >> 11, s0 = tok0 & 2047;
        if (u == 0) {
#pragma unroll
            for (int i = 0; i < 46; ++i) { const int s = s0 - 15 + i;
                if (s >= 0 && s < SEQ) { const unsigned v = *(const unsigned*)(AG + (size_t)(b * SEQ + s) * DM + c); in[i] = (f32x2){bf_lo(v), bf_hi(v)}; } else in[i] = (f32x2){0.f, 0.f}; }
        } else {
#pragma unroll
            for (int i = 0; i < 30; ++i) in[i] = in[i + 16];
#pragma unroll
            for (int i = 0; i < 16; ++i) in[30 + i] = (f32x2){bf_lo(nx[i]), bf_hi(nx[i])};
        }
        if (u + 1 < nun) {
#pragma unroll
            for (int i = 0; i < 16; ++i) { const int s = s0 + 31 + i; nx[i] = (s < SEQ) ? *(const unsigned*)(AG + (size_t)(b * SEQ + s) * DM + c) : 0u; }
        }
        f32x2 acc[16];
#pragma unroll
        for (int t = 0; t < 16; ++t) acc[t] = bias;
#pragma unroll
        for (int j = 0; j < 31; ++j) { const unsigned wp = wl[j * 512 + tid]; const f32x2 w = (f32x2){bf_lo(wp), bf_hi(wp)};
#pragma unroll
            for (int t = 0; t < 16; ++t) acc[t] += w * in[t + j]; }
#pragma unroll
        for (int t = 0; t < 16; ++t) { red[(2 * t) * 512 + tid] = acc[t].x + acc[t].y; red[(2 * t + 1) * 512 + tid] = acc[t].x * acc[t].x + acc[t].y * acc[t].y; }
        __syncthreads();
#pragma unroll
        for (int r = 0; r < 2; ++r) { const int tk = wid * 2 + r; float sm = 0.f, sq = 0.f;
#pragma unroll
            for (int i = 0; i < 8; ++i) { sm += red[(2 * tk) * 512 + lane + 64 * i]; sq += red[(2 * tk + 1) * 512 + lane + 64 * i]; }
            sm = wave_sum(sm); sq = wave_sum(sq);
            if (lane == 0) { const float mean = sm * (1.f / DM), var = sq * (1.f / DM) - mean * mean; stat[2 * tk] = mean; stat[2 * tk + 1] = __builtin_amdgcn_rsqf(var + EPS); } }
        __syncthreads();
#pragma unroll
        for (int t = 0; t < 16; ++t) { const float mean = stat[2 * t], rstd = stat[2 * t + 1];
            const float y0 = (acc[t].x - mean) * rstd * g.x + bb.x, y1 = (acc[t].y - mean) * rstd * g.y + bb.y;
            *(unsigned*)(CA + (size_t)(tok0 + t) * DM + c) = cvt_pk_bf16(y0 * fast_sigmoid(y0), y1 * fast_sigmoid(y1)); }
        __syncthreads();
    }
}

constexpr int SG_WL = 0, SG_GL = 128 * 272, SG_ST = 2 * 128 * 272;
template <bool STORE> __device__ __forceinline__ void sgu_unit(LAS unsigned char* lds, const bf16_t* GEL, const float* STAT, bf16_t* GU, const float* sw, const float* sb, const float* lng, const float* lnb, int unit, const int wave_s) {
    const int tid_ = wave_s * 64 + lane_op();
    const int tid = tid_, lane = tid & 63, wid = wave_s;
    const int chunk = unit >> 3, g = unit & 7, tok0 = chunk * 128, c0 = g * 128;
    LAS float* st = (LAS float*)(lds + SG_ST);
    u32x4 gv4[4];
#pragma unroll
    for (int i = 0; i < 4; ++i) { const int id = tid + 512 * i; gv4[i] = *(const u32x4*)(GEL + (size_t)(tok0 + (id >> 4)) * DM + c0 + (id & 15) * 8); }
    if (tid < 128) { const f32x4* sp = (const f32x4*)(STAT + (size_t)(tok0 + tid) * 32); float s = 0.f, s2 = 0.f;
#pragma unroll
        for (int i = 0; i < 8; ++i) { const f32x4 v = sp[i]; s += v[0] + v[2]; s2 += v[1] + v[3]; }
        const float mean = s * (1.f / DM), var = s2 * (1.f / DM) - mean * mean; st[2 * tid] = mean; st[2 * tid + 1] = __builtin_amdgcn_rsqf(var + EPS); }
#pragma unroll
    for (int i = 0; i < 8; ++i) { const int id = tid + 512 * i, t = id >> 5, s4 = (id & 31) * 4; const f32x4 v = *(const f32x4*)(sw + (size_t)g * 16384 + t * 128 + s4);
        u32x2 w; w.x = cvt_pk_bf16(v[0], v[1]); w.y = cvt_pk_bf16(v[2], v[3]); *(LAS u32x2*)(lds + SG_WL + t * 272 + s4 * 2) = w; }
    __syncthreads();
#pragma unroll
    for (int i = 0; i < 4; ++i) { const int id = tid + 512 * i, s = id >> 4, cc = (id & 15) * 8; const u32x4 v = gv4[i];
        const float mean = st[2 * s], rstd = st[2 * s + 1];
        const f32x4 g0 = *(const f32x4*)(lng + c0 + cc), g1 = *(const f32x4*)(lng + c0 + cc + 4), b0 = *(const f32x4*)(lnb + c0 + cc), b1 = *(const f32x4*)(lnb + c0 + cc + 4);
        float x[8] = {bf_lo(v.x), bf_hi(v.x), bf_lo(v.y), bf_hi(v.y), bf_lo(v.z), bf_hi(v.z), bf_lo(v.w), bf_hi(v.w)};
#pragma unroll
        for (int k = 0; k < 8; ++k) { const float gg = k < 4 ? g0[k & 3] : g1[k & 3], bb = k < 4 ? b0[k & 3] : b1[k & 3]; const float y = (x[k] - mean) * rstd * gg + bb;
            *(LAS bf16_t*)(lds + SG_GL + (cc + k) * 272 + s * 2) = (bf16_t)(cvt_pk_bf16(y, 0.f) & 0xffffu); } }
    __syncthreads();
    const int cb = wid & 3, th = wid >> 2, q = lane & 31, hi = lane >> 5;
    f32x16 d0 = {}, d1 = {};
#pragma unroll
    for (int ks = 0; ks < 8; ++ks) {
        const bf16x8 af = *(const LAS bf16x8*)(lds + SG_GL + (32 * cb + q) * 272 + (16 * ks + 8 * hi) * 2);
        const bf16x8 b0 = *(const LAS bf16x8*)(lds + SG_WL + (64 * th + q) * 272 + (16 * ks + 8 * hi) * 2);
        const bf16x8 b1 = *(const LAS bf16x8*)(lds + SG_WL + (64 * th + 32 + q) * 272 + (16 * ks + 8 * hi) * 2);
        d0 = __builtin_amdgcn_mfma_f32_32x32x16_bf16(af, b0, d0, 0, 0, 0);
        d1 = __builtin_amdgcn_mfma_f32_32x32x16_bf16(af, b1, d1, 0, 0, 0);
    }
#pragma unroll
    for (int tb = 0; tb < 2; ++tb) { const int t = 64 * th + 32 * tb + q; const float bias = sb[g * 128 + t];
        bf16_t* rowp = GU + (size_t)(tok0 + t) * DM + c0 + 32 * cb + 4 * hi;
#pragma unroll
        for (int i = 0; i < 4; ++i) { const u32x2 u = *(const u32x2*)(rowp + 8 * i);
            const float m0 = (tb ? d1[4 * i] : d0[4 * i]) + bias, m1 = (tb ? d1[4 * i + 1] : d0[4 * i + 1]) + bias, m2 = (tb ? d1[4 * i + 2] : d0[4 * i + 2]) + bias, m3 = (tb ? d1[4 * i + 3] : d0[4 * i + 3]) + bias;
            u32x2 w; w.x = cvt_pk_bf16(bf_lo(u.x) * m0, bf_hi(u.x) * m1); w.y = cvt_pk_bf16(bf_lo(u.y) * m2, bf_hi(u.y) * m3);
            if (STORE) *(u32x2*)(rowp + 8 * i) = w; } }
    __syncthreads();
}

constexpr int AT_SLOT = 16384, AT_VOFF = 4 * AT_SLOT;
__device__ __forceinline__ float max3f(float a, float b, float c) { return __builtin_fmaxf(__builtin_fmaxf(a, b), c); }
__device__ __forceinline__ void glds16(const void* gsrc, unsigned lds_dst) { unsigned keep;
    asm volatile("s_mov_b32 %0, m0\n\ts_mov_b32 m0, %2\n\ts_nop 0\n\tglobal_load_lds_dwordx4 %1, off\n\ts_mov_b32 m0, %0" : "=&s"(keep) : "v"(gsrc), "s"(lds_dst) : "memory"); }
template <bool STORE> __device__ __forceinline__ void attn_unit(LAS unsigned char* lds, bf16_t* Q, const bf16_t* Kg, const bf16_t* VT, const float* subg, float lam, float outscale, int unit, const int wave_s) {
    const int tid_ = wave_s * 64 + lane_op();
    const int tid = tid_, lane = tid & 63, wid = wave_s, q = lane & 31, hi = lane >> 5;
    const int bh = unit >> 4, qb = unit & 15, b = bh >> 3, h = bh & 7, map = wid >> 2;
    const int qrow0 = qb * 128 + 32 * (wid & 3);
    const int td = qrow0 >> 6;
    bf16x8 qf[4];
    { const bf16_t* Qp = Q + (size_t)(b * SEQ + qrow0 + q) * DM + h * 128 + map * 64 + 8 * hi;
#pragma unroll
      for (int d0 = 0; d0 < 4; ++d0) qf[d0] = *(const bf16x8*)(Qp + 16 * d0); }
    const float sl = __int_as_float(__builtin_amdgcn_readfirstlane(__float_as_int(exp2f(-(float)(h + 1)) * LOG2E)));
    float sself;
    { const bf16_t* Kp = Kg + (size_t)(b * SEQ + qrow0 + q) * DM + h * 128 + map * 64 + 8 * hi; float a = 0.f;
#pragma unroll
      for (int d0 = 0; d0 < 4; ++d0) { const u32x4 kv = *(const u32x4*)(Kp + 16 * d0); const u32x4 qv = __builtin_bit_cast(u32x4, qf[d0]);
#pragma unroll
          for (int j = 0; j < 4; ++j) a += bf_lo(kv[j]) * bf_lo(qv[j]) + bf_hi(kv[j]) * bf_hi(qv[j]); }
      sself = swap_add(a); }
    const unsigned lds0 = (unsigned)(uintptr_t)lds;
    const bf16_t* kgp; const bf16_t* vgp;
    { const int kr = 8 * wid + (lane >> 4), kc = (lane & 15) ^ (kr & 15); kgp = Kg + (size_t)(b * SEQ + kr) * DM + h * 128 + kc * 8;
      const int vr = 16 * wid + (lane >> 3), vc = (lane & 7) ^ ((vr >> 1) & 7); vgp = VT + (size_t)(h * 128 + vr) * T + b * SEQ + vc * 8; }
    const int kx1 = ((((lane & 15) ^ ((8 * wid + (lane >> 4) + 4) & 15)) - ((lane & 15) ^ ((8 * wid + (lane >> 4)) & 15))) * 8) + 4 * DM;
    const int vx1 = ((((lane & 7) ^ (((16 * wid + (lane >> 3) + 8) >> 1) & 7)) - ((lane & 7) ^ (((16 * wid + (lane >> 3)) >> 1) & 7))) * 8) + 8 * T;
    const unsigned kdst = lds0 + wid * 2048, vdst = lds0 + AT_VOFF + wid * 2048;
#define AT_ISSUE_K(tt) do { const unsigned so_ = (unsigned)(((tt) & 3) * AT_SLOT); const bf16_t* kp_ = kgp + (size_t)(tt) * 64 * DM; \
        glds16(kp_, (unsigned)__builtin_amdgcn_readfirstlane(kdst + so_)); glds16(kp_ + kx1, (unsigned)__builtin_amdgcn_readfirstlane(kdst + so_ + 1024)); } while (0)
#define AT_ISSUE_V(tt) do { const unsigned so_ = (unsigned)(((tt) & 3) * AT_SLOT); const bf16_t* vp_ = vgp + (tt) * 64; \
        glds16(vp_, (unsigned)__builtin_amdgcn_readfirstlane(vdst + so_)); glds16(vp_ + vx1, (unsigned)__builtin_amdgcn_readfirstlane(vdst + so_ + 1024)); } while (0)
#define AT_BAR(N) asm volatile("s_waitcnt vmcnt(" #N ") lgkmcnt(0)\n\ts_barrier" ::: "memory")
    AT_ISSUE_K(0); AT_ISSUE_V(0); AT_ISSUE_K(1); AT_ISSUE_V(1); AT_ISSUE_K(2); AT_ISSUE_V(2); AT_ISSUE_K(3);
    AT_BAR(8);
    f32x16 o[4]; o[0] = f32x16{}; o[1] = f32x16{}; o[2] = f32x16{}; o[3] = f32x16{};
    float mref = sself + 6.0f, lsum = 0.f;
    const int koff = q * 256 + (((map * 8 + hi) ^ (q & 15)) << 4), voff = AT_VOFF + q * 128 + ((hi ^ ((q >> 1) & 7)) << 4);
    const float qposf = (float)(qrow0 + q - 4 * hi);
    f32x16 x0, x1, n0, n1;
#define AT_CINIT(tt, sgn, c0, c1) do { const float ss_ = (sgn) * sl, s2_ = ss_ + ss_, s3_ = s2_ + ss_, s4_ = s2_ + s2_, s8_ = s4_ + s4_, s16_ = s8_ + s8_; float g0_ = ss_ * ((float)(64 * (tt)) - qposf) - mref, g1_ = g0_ + (s16_ + s16_); \
        _Pragma("unroll") for (int g = 0; g < 4; ++g) { c0[4 * g] = g0_; c0[4 * g + 1] = g0_ + ss_; c0[4 * g + 2] = g0_ + s2_; c0[4 * g + 3] = g0_ + s3_; \
            c1[4 * g] = g1_; c1[4 * g + 1] = g1_ + ss_; c1[4 * g + 2] = g1_ + s2_; c1[4 * g + 3] = g1_ + s3_; g0_ += s8_; g1_ += s8_; } } while (0)
#define AT_QK(kslot, c0, c1) do { _Pragma("unroll") for (int d0 = 0; d0 < 4; ++d0) { \
        const bf16x8 k0_ = *(const LAS bf16x8*)(lds + (kslot) + (koff ^ (d0 << 5))); const bf16x8 k1_ = *(const LAS bf16x8*)(lds + (kslot) + (koff ^ (d0 << 5)) + 8192); \
        c0 = __builtin_amdgcn_mfma_f32_32x32x16_bf16(k0_, qf[d0], c0, 0, 0, 0); c1 = __builtin_amdgcn_mfma_f32_32x32x16_bf16(k1_, qf[d0], c1, 0, 0, 0); } } while (0)
#define AT_DIAG(tt, c0, c1) do { const float base_ = qposf - (float)(64 * (tt)); \
        _Pragma("unroll") for (int r = 0; r < 16; ++r) { const float cr_ = (float)((r & 3) + 8 * (r >> 2)); c0[r] -= sl * fabsf(base_ - cr_); c1[r] -= sl * fabsf(base_ - 32.f - cr_); } } while (0)
#define AT_MAX(c0, c1, rm) do { float a_ = fmaxf(c0[0], c1[0]), b_ = fmaxf(c0[1], c1[1]); \
        _Pragma("unroll") for (int r = 2; r < 16; r += 2) { a_ = max3f(a_, c0[r], c1[r]); b_ = max3f(b_, c0[r + 1], c1[r + 1]); } rm = swap_max(fmaxf(a_, b_)); } while (0)
    { const float sg0 = td > 0 ? 1.f : 0.f;
      AT_CINIT(0, sg0, x0, x1); AT_QK(0, x0, x1);
      if (td == 0) AT_DIAG(0, x0, x1);
      float rm; AT_MAX(x0, x1, rm);
      if (__any(rm > 8.0f)) { const float dl = fmaxf(rm, 0.f); mref += dl;
#pragma unroll
          for (int r = 0; r < 16; ++r) { x0[r] -= dl; x1[r] -= dl; } } }
    asm volatile("s_waitcnt lgkmcnt(0)\n\ts_barrier" ::: "memory");
#define AT_SB() __builtin_amdgcn_sched_barrier(0)
#define AT_VRD(dst, kk) do { _Pragma("unroll") for (int d = 0; d < 4; ++d) dst[d] = *(const LAS bf16x8*)(lds + vcur_ + (voff ^ ((kk) << 5)) + d * 4096); } while (0)
#define AT_PV(src, kk) do { const bf16x8 pf_ = __builtin_bit_cast(bf16x8, pw_[kk]); _Pragma("unroll") for (int d = 0; d < 4; ++d) o[d] = __builtin_amdgcn_mfma_f32_32x32x16_bf16(src[d], pf_, o[d], 0, 0, 0); } while (0)
#define AT_BODY(MODE, t, SGN, x0, x1, n0, n1) do { \
        const bool pre_ = ((MODE) != 2) && ((t) + 4 < 32); \
        if (pre_) { AT_ISSUE_K((t) + 4); AT_ISSUE_V((t) + 3); } else if (((MODE) != 2) && ((t) + 3 < 32)) { AT_ISSUE_V((t) + 3); } \
        bf16x8 kf_[4], kg_[4], va_[4], vb_[4]; const int ks_ = (((t) + 1) & 3) * AT_SLOT, vcur_ = ((t) & 3) * AT_SLOT; \
        if ((MODE) != 2) { \
            _Pragma("unroll") for (int d0 = 0; d0 < 2; ++d0) { kf_[2 * d0] = *(const LAS bf16x8*)(lds + ks_ + (koff ^ (d0 << 5))); kf_[2 * d0 + 1] = *(const LAS bf16x8*)(lds + ks_ + (koff ^ (d0 << 5)) + 8192); } \
            AT_CINIT((t) + 1, ((MODE) == 1 ? 0.f : (SGN)), n0, n1); } \
        AT_SB(); \
        if ((MODE) != 2) { \
            _Pragma("unroll") for (int d0 = 0; d0 < 2; ++d0) { kg_[2 * d0] = *(const LAS bf16x8*)(lds + ks_ + (koff ^ ((d0 + 2) << 5))); kg_[2 * d0 + 1] = *(const LAS bf16x8*)(lds + ks_ + (koff ^ ((d0 + 2) << 5)) + 8192); } \
            _Pragma("unroll") for (int d0 = 0; d0 < 2; ++d0) { n0 = __builtin_amdgcn_mfma_f32_32x32x16_bf16(kf_[2 * d0], qf[d0], n0, 0, 0, 0); n1 = __builtin_amdgcn_mfma_f32_32x32x16_bf16(kf_[2 * d0 + 1], qf[d0], n1, 0, 0, 0); } \
            _Pragma("unroll") for (int d0 = 0; d0 < 2; ++d0) { n0 = __builtin_amdgcn_mfma_f32_32x32x16_bf16(kg_[2 * d0], qf[d0 + 2], n0, 0, 0, 0); n1 = __builtin_amdgcn_mfma_f32_32x32x16_bf16(kg_[2 * d0 + 1], qf[d0 + 2], n1, 0, 0, 0); } } \
        AT_VRD(va_, 0); \
        float ps_ = 0.f; u32x4 pw_[4]; \
        _Pragma("unroll") for (int r = 0; r < 16; ++r) { x0[r] = __builtin_amdgcn_exp2f(x0[r]); x1[r] = __builtin_amdgcn_exp2f(x1[r]); ps_ += x0[r] + x1[r]; } \
        lsum += ps_; \
        pw_[0].x = cvt_pk_bf16(x0[0], x0[1]); pw_[0].y = cvt_pk_bf16(x0[2], x0[3]); pw_[0].z = cvt_pk_bf16(x0[4], x0[5]); pw_[0].w = cvt_pk_bf16(x0[6], x0[7]); \
        pw_[1].x = cvt_pk_bf16(x0[8], x0[9]); pw_[1].y = cvt_pk_bf16(x0[10], x0[11]); pw_[1].z = cvt_pk_bf16(x0[12], x0[13]); pw_[1].w = cvt_pk_bf16(x0[14], x0[15]); \
        pw_[2].x = cvt_pk_bf16(x1[0], x1[1]); pw_[2].y = cvt_pk_bf16(x1[2], x1[3]); pw_[2].z = cvt_pk_bf16(x1[4], x1[5]); pw_[2].w = cvt_pk_bf16(x1[6], x1[7]); \
        pw_[3].x = cvt_pk_bf16(x1[8], x1[9]); pw_[3].y = cvt_pk_bf16(x1[10], x1[11]); pw_[3].z = cvt_pk_bf16(x1[12], x1[13]); pw_[3].w = cvt_pk_bf16(x1[14], x1[15]); \
        AT_SB(); \
        AT_VRD(vb_, 1); AT_PV(va_, 0); AT_SB(); \
        AT_VRD(va_, 2); AT_PV(vb_, 1); AT_SB(); \
        float rm_ = 0.f; \
        AT_VRD(vb_, 3); AT_PV(va_, 2); \
        if ((MODE) != 2) { if ((MODE) == 1) AT_DIAG((t) + 1, n0, n1); AT_MAX(n0, n1, rm_); } \
        AT_SB(); \
        AT_PV(vb_, 3); \
        if ((MODE) != 2) { \
            if (__any(rm_ > 8.0f)) { const float dl_ = fmaxf(rm_, 0.f); mref += dl_; const float al_ = __builtin_amdgcn_exp2f(-dl_); lsum *= al_; \
                _Pragma("unroll") for (int r = 0; r < 16; ++r) { n0[r] -= dl_; n1[r] -= dl_; } \
                _Pragma("unroll") for (int d = 0; d < 4; ++d) _Pragma("unroll") for (int r = 0; r < 16; ++r) o[d][r] *= al_; } \
            } \
        if (pre_) AT_BAR(8); else AT_BAR(0); } while (0)
    {
        int t = 0;
        for (; t + 2 < td; t += 2) { AT_BODY(0, t, 1.0f, x0, x1, n0, n1); AT_BODY(0, t + 1, 1.0f, n0, n1, x0, x1); }
        if (t + 1 < td) { AT_BODY(0, t, 1.0f, x0, x1, n0, n1); x0 = n0; x1 = n1; ++t; }
        if (td >= 1) { AT_BODY(1, t, 0.0f, x0, x1, n0, n1); x0 = n0; x1 = n1; ++t; }
        for (; t + 1 < 31; t += 2) { AT_BODY(0, t, -1.0f, x0, x1, n0, n1); AT_BODY(0, t + 1, -1.0f, n0, n1, x0, x1); }
        if (t < 31) { AT_BODY(0, t, -1.0f, x0, x1, n0, n1); x0 = n0; x1 = n1; ++t; }
        AT_BODY(2, 31, 0.0f, x0, x1, n0, n1);
    }
#undef AT_BODY
#undef AT_ISSUE_K
#undef AT_ISSUE_V
#undef AT_BAR
#undef AT_SB
#undef AT_VRD
#undef AT_PV
#undef AT_CINIT
#undef AT_QK
#undef AT_DIAG
#undef AT_MAX
    const float inv = 1.0f / swap_add(lsum);
    LAS float* xb = (LAS float*)lds + (wid & 3) * 4096;
    if (map == 1) {
#pragma unroll
        for (int d = 0; d < 4; ++d)
#pragma unroll
            for (int r = 0; r < 16; ++r) xb[(d * 16 + r) * 64 + lane] = o[d][r] * inv;
    }
    __syncthreads();
    if (STORE && map == 0) {
        float ss = 0.f;
#pragma unroll
        for (int d = 0; d < 4; ++d)
#pragma unroll
            for (int r = 0; r < 16; ++r) { const float v = o[d][r] * inv - lam * xb[(d * 16 + r) * 64 + lane]; o[d][r] = v; ss += v * v; }
        ss = swap_add(ss);
        const float rstd = outscale / sqrtf(ss * (1.f / 128.f) + EPS);
        const int l2 = lane_op();
        bf16_t* orow = Q + (size_t)(b * SEQ + qrow0 + (l2 & 31)) * DM + h * 128 + 4 * (l2 >> 5);
#pragma unroll
        for (int d = 0; d < 4; ++d)
#pragma unroll
            for (int i = 0; i < 4; ++i) { const f32x4 gg = *(const f32x4*)(subg + 32 * d + 8 * i + 4 * (l2 >> 5));
                u32x2 w; w.x = cvt_pk_bf16(o[d][4 * i] * rstd * gg[0], o[d][4 * i + 1] * rstd * gg[1]); w.y = cvt_pk_bf16(o[d][4 * i + 2] * rstd * gg[2], o[d][4 * i + 3] * rstd * gg[3]);
                *(u32x2*)(orow + 32 * d + 8 * i) = w; }
    }
    __syncthreads();
}


#define XB_TMO      128
#define XB_XCNT(j)  (256  + 64 * (j))
#define XB_XSUB(j)  (1280 + 64 * (j))
#define XB_XGEN(j)  (2304 + 64 * (j))
#define XB_TOP      3328
#define XB_TOPGEN   3392
#define XCD_BAR_WORDS 3456
#define XB_SPIN_CAP (1u << 22)
__device__ __forceinline__ unsigned xb_ld(unsigned* p)              { return __hip_atomic_load(p, __ATOMIC_RELAXED, __HIP_MEMORY_SCOPE_AGENT); }
__device__ __forceinline__ unsigned xb_add(unsigned* p, unsigned v) { return __hip_atomic_fetch_add(p, v, __ATOMIC_RELAXED, __HIP_MEMORY_SCOPE_AGENT); }
__device__ __forceinline__ unsigned xb_xcc_id() { return (unsigned)__builtin_amdgcn_s_getreg((3 << 11) | 20) & 0xFu; }
#define XB_SPIN(cond, bar) do { unsigned _sp = 0; while (cond) { __builtin_amdgcn_s_sleep(1); \
    if ((++_sp & 255u) == 0u) { if (xb_ld(&(bar)[XB_TMO])) break; if (_sp > XB_SPIN_CAP) { atomicAdd(&(bar)[XB_TMO], 1u); break; } } } } while (0)
struct XcdBarrier { unsigned* bar; unsigned x; volatile LAS unsigned* st; };
__device__ __forceinline__ XcdBarrier xcd_barrier_post(unsigned* bar, volatile LAS unsigned* st, bool t0) {
    XcdBarrier b; b.bar = bar; b.x = xb_xcc_id(); b.st = st;
    if (t0) (void)xb_add(&bar[XB_XCNT(b.x)], 1u);
    return b;
}
__device__ __forceinline__ void xcd_barrier_complete(unsigned* bar, unsigned x, unsigned& nloc, unsigned& nx) {
    const unsigned G = gridDim.x * gridDim.y * gridDim.z;
    unsigned sum, cnt, mine, sp = 0u;
    for (;;) {
        sum = 0u; cnt = 0u; mine = 0u;
#pragma unroll
        for (unsigned j = 0; j < 16; ++j) { const unsigned c = xb_ld(&bar[XB_XCNT(j)]); sum += c; cnt += (c > 0u) ? 1u : 0u; mine = (j == x) ? c : mine; }
        if (sum == G) break;
        __builtin_amdgcn_s_sleep(1);
        if ((++sp & 255u) == 0u) { if (xb_ld(&bar[XB_TMO])) break; if (sp > XB_SPIN_CAP) { atomicAdd(&bar[XB_TMO], 1u); break; } }
    }
    nloc = mine > 0u ? mine : 1u; nx = cnt > 0u ? cnt : 1u;
}
__device__ __forceinline__ void xcd_barrier(const XcdBarrier& b, bool t0) {
    asm volatile("s_waitcnt vmcnt(0)" ::: "memory");
    __syncthreads();
    if (t0) {
        unsigned* bar = b.bar;
        __builtin_amdgcn_s_waitcnt(0);
        unsigned nloc = b.st[0], nx = b.st[1];
        if (nloc == 0u) { xcd_barrier_complete(bar, b.x, nloc, nx); b.st[0] = nloc; b.st[1] = nx; }
        const unsigned old = xb_add(&bar[XB_XSUB(b.x)], 1u);
        const unsigned gen = old / nloc;
        if (old + 1u == (gen + 1u) * nloc) {
            __builtin_amdgcn_fence(__ATOMIC_RELEASE, "agent");
            asm volatile("s_waitcnt vmcnt(0)" ::: "memory");
            const unsigned og = xb_add(&bar[XB_TOP], 1u);
            const unsigned tg = og / nx;
            if (og + 1u == (tg + 1u) * nx) xb_add(&bar[XB_TOPGEN], 1u);
            else XB_SPIN(xb_ld(&bar[XB_TOPGEN]) == tg, bar);
            __builtin_amdgcn_fence(__ATOMIC_ACQUIRE, "agent");
            xb_add(&bar[XB_XGEN(b.x)], 1u);
            asm volatile("s_waitcnt vmcnt(0)" ::: "memory");
        } else {
            XB_SPIN(xb_ld(&bar[XB_XGEN(b.x)]) == gen, bar);
            __builtin_amdgcn_fence(__ATOMIC_ACQUIRE, "agent");
            asm volatile("s_waitcnt vmcnt(0)" ::: "memory");
        }
    }
    __syncthreads();
}

constexpr int LDS_BYTES = 147456;
#ifndef PROBE_GEMM2
#define PROBE_GEMM2 0
#endif
#ifndef FUSE_NORM
#define FUSE_NORM 1
#endif
#if PROBE_GEMM2
constexpr unsigned long long SEQ_PACK = 0x7665543322100ull; constexpr int NPL = 13;
#elif FUSE_NORM
constexpr unsigned long long SEQ_PACK = 0x7653210ull; constexpr int NPL = 7;
#else
constexpr unsigned long long SEQ_PACK = 0x76543210ull; constexpr int NPL = 8;
#endif
constexpr int N_PHASES = 1 + NPL * DEPTH;
#ifndef PROBE_GEMM2
#define PROBE_GEMM2 0
#endif
#ifndef PROBE_SYNC
#define PROBE_SYNC 0
#endif
#ifndef PROBE_CONV2
#define PROBE_CONV2 0
#endif
#ifndef PROBE_P02
#define PROBE_P02 0
#endif
#ifndef PROBE_SGU2
#define PROBE_SGU2 0
#endif
#ifndef PROBE_ATT2
#define PROBE_ATT2 0
#endif
#ifndef PHMASK
#define PHMASK 0xfff
#endif

typedef const __attribute__((address_space(4))) Args* CArgs;
#define PH_ON(bit) if constexpr ((PHMASK & (bit)) != 0)
__global__ void __launch_bounds__(NTHREADS, 2) fwd_megakernel(Args a_unused) {
    extern __shared__ __attribute__((aligned(16))) unsigned char lds_raw[];
    LAS unsigned char* lds = (LAS unsigned char*)lds_raw;
    CArgs ap0 = (CArgs)__builtin_amdgcn_kernarg_segment_ptr();
    const int lo = ap0->lo, hi = ap0->hi;
    const int wave = __builtin_amdgcn_readfirstlane((int)threadIdx.x >> 6);
    const bool t0 = (threadIdx.x == 0);
    volatile LAS unsigned* bst = (volatile LAS unsigned*)(lds + 131072 + 1024);
    if (t0) { bst[0] = 0u; bst[1] = 0u; }
    __syncthreads();
    const XcdBarrier gbar = xcd_barrier_post((unsigned*)ap0->ws, bst, t0);
    for (int ph = lo; ph < hi; ++ph) {
        CArgs ap = ap0; asm volatile("" : "+s"(ap));
        const int G = gridDim.x, bx = blockIdx.x;
        const int vcu = (G % 8 == 0) ? (bx % 8) * (G / 8) + bx / 8 : bx;
        const int gw = vcu * NWAVES + wave, NGW = G * NWAVES;
        unsigned char* ws = ap->ws;
        bf16_t* W = (bf16_t*)(ws + WS_W);
        bf16_t* XN = (bf16_t*)(ws + WS_XN);
        if (ph == 0) { PH_ON(256) { for (int rep_ = 0; rep_ < 1 + PROBE_P02; ++rep_) {
            const int lane = lane_op();
            convert_weights(ap, 0, lds, gw, NGW, wave, lane);
            const float* x = ap->in[I_X]; const float* g = ap->in[I_NMPRE];
            for (int m = gw; m < T; m += 4 * NGW) rms_rows4_to_bf16(x + (size_t)m * DM, (size_t)NGW * DM, g, XN + (size_t)m * DM, lane);
            __syncthreads(); } }
        } else {
            const int l = (ph - 1) / NPL, k = (int)((SEQ_PACK >> (4 * ((ph - 1) % NPL))) & 15ull);
            if (k == 0) { PH_ON(1) {
                SchedIn S{XN, W + WO_IN, G, bx};
                EpiIn E{(bf16_t*)(ws + WS_AG), (bf16_t*)(ws + WS_Q), (bf16_t*)(ws + WS_K), (bf16_t*)(ws + WS_GU), (bf16_t*)(ws + WS_GEL), (bf16_t*)(ws + WS_VT), (float*)(ws + WS_STAT)};
                pg8::gemm_phase<EpiIn, SchedIn>(lds, wave, DM, S, E); }
            } else if (k == 1) { PH_ON(2) {
                const int per = (1024 + G - 1) / G;
                PH_ON(512) {
                    const int lane = lane_op();
                    const float la = wave_sum(ap->in[I_LQ1][l * 64 + lane] * ap->in[I_LK1][l * 64 + lane]), lb = wave_sum(ap->in[I_LQ2][l * 64 + lane] * ap->in[I_LK2][l * 64 + lane]);
                    const float lam_init = 0.8f - 0.6f * expf(-0.3f * (float)l);
                    const float lam = __int_as_float(__builtin_amdgcn_readfirstlane(__float_as_int(expf(la) - expf(lb) + lam_init)));
                    const float oscale = __int_as_float(__builtin_amdgcn_readfirstlane(__float_as_int(1.0f - lam_init)));
                    const float* subg = ap->in[I_SUBG] + l * 128;
                    if constexpr (PROBE_ATT2 != 0) { for (int i = 0; i < per; ++i) { const int u = vcu * per + i; if (u < 1024) attn_unit<false>(lds, (bf16_t*)(ws + WS_Q), (const bf16_t*)(ws + WS_K), (const bf16_t*)(ws + WS_VT), subg, lam, oscale, u, wave); } }
                    for (int i = 0; i < per; ++i) { const int u = vcu * per + i; if (u < 1024) attn_unit<true>(lds, (bf16_t*)(ws + WS_Q), (const bf16_t*)(ws + WS_K), (const bf16_t*)(ws + WS_VT), subg, lam, oscale, u, wave); }
                }
                PH_ON(1024) {
                    const float* cw = ap->in[I_CONVW] + (size_t)l * 31 * DM; const float* cb = ap->in[I_CONVB] + l * DM; const float* lg = ap->in[I_CLNG] + l * DM; const float* lb2 = ap->in[I_CLNB] + l * DM;
                    for (int rep_ = 0; rep_ < 1 + PROBE_CONV2; ++rep_) { const int u0 = vcu * per; int nun = 1024 - u0; nun = nun < 0 ? 0 : (nun > per ? per : nun);
                        if ((128 % per) == 0) conv_run(lds, (const bf16_t*)(ws + WS_AG), (bf16_t*)(ws + WS_CA), cw, cb, lg, lb2, u0, nun, wave);
                        else for (int i = 0; i < nun; ++i) conv_run(lds, (const bf16_t*)(ws + WS_AG), (bf16_t*)(ws + WS_CA), cw, cb, lg, lb2, u0 + i, 1, wave); }
                }
                PH_ON(2048) {
                    const float* sw = ap->in[I_SGUW] + (size_t)l * 8 * 16384; const float* sb = ap->in[I_SGUB] + l * 1024; const float* lg = ap->in[I_SLNG] + l * DM; const float* lb2 = ap->in[I_SLNB] + l * DM;
                    if constexpr (PROBE_SGU2 != 0) { for (int i = 0; i < per; ++i) { const int u = vcu * per + i; if (u < 1024) sgu_unit<false>(lds, (const bf16_t*)(ws + WS_GEL), (const float*)(ws + WS_STAT), (bf16_t*)(ws + WS_GU), sw, sb, lg, lb2, u, wave); } }
                    for (int i = 0; i < per; ++i) { const int u = vcu * per + i; if (u < 1024) sgu_unit<true>(lds, (const bf16_t*)(ws + WS_GEL), (const float*)(ws + WS_STAT), (bf16_t*)(ws + WS_GU), sw, sb, lg, lb2, u, wave); }
                } }
            } else if (k == 2) { PH_ON(4) {
                SchedProj S{ws, G, bx};
                EpiProj E{(bf16_t*)(ws + WS_GS), (float*)(ws + WS_SB), (bf16_t*)(ws + WS_MIXPRE), ap->in[I_BGATE] + l * 3072};
                pg8::gemm_phase<EpiProj, SchedProj>(lds, wave, DM, S, E); }
            } else if (k == 3) { PH_ON(8) {
                SchedSimple S{(const bf16_t*)(ws + WS_MIXPRE), W + WO_OUT, 64, 4, DM, G, bx};
#if FUSE_NORM
                float* out = ap->out;
                EpiNormRes E{(l == 0) ? ap->in[I_X] : out, out, ap->in[I_NMPOST] + l * DM, ap->in[I_NFPRE] + l * DM, XN, (float*)(ws + WS_XBUF) + (size_t)(l * 2 + 0) * 2 * T * 4, (unsigned*)(ws + WS_CNT) + (l * 2 + 0) * 2 * 64 * 64, lds};
                pg8::gemm_phase<EpiNormRes, SchedSimple>(lds, wave, DM, S, E);
#else
                EpiF32 E{(float*)(ws + WS_MIX), DM};
                pg8::gemm_phase<EpiF32, SchedSimple>(lds, wave, DM, S, E);
#endif
                }
            } else if (k == 4) { PH_ON(16) {
                const int lane = lane_op();
                float* out = ap->out; const float* xin = (l == 0) ? ap->in[I_X] : out; const float* MIX = (const float*)(ws + WS_MIX);
                const float* gp = ap->in[I_NMPOST] + l * DM; const float* gn = ap->in[I_NFPRE] + l * DM;
                for (int m = gw; m < T; m += NGW) resid_norm_row(MIX + (size_t)m * DM, xin + (size_t)m * DM, out + (size_t)m * DM, gp, gn, XN + (size_t)m * DM, lane); }
            } else if (k == 5) { PH_ON(32) {
                SchedSimple S{XN, W + WO_UP, 64, 16, DM, G, bx};
                EpiRelu2 E{(bf16_t*)(ws + WS_H), DFF};
                pg8::gemm_phase<EpiRelu2, SchedSimple>(lds, wave, DM, S, E); }
            } else if (k == 6) { PH_ON(64) {
                SchedSimple S{(const bf16_t*)(ws + WS_H), W + WO_DOWN, 64, 4, DFF, G, bx};
#if FUSE_NORM
                float* out = ap->out;
                EpiNormRes E{out, out, ap->in[I_NFPOST] + l * DM, (l + 1 < DEPTH) ? ap->in[I_NMPRE] + (l + 1) * DM : nullptr, XN, (float*)(ws + WS_XBUF) + (size_t)(l * 2 + 1) * 2 * T * 4, (unsigned*)(ws + WS_CNT) + (l * 2 + 1) * 2 * 64 * 64, lds};
                pg8::gemm_phase<EpiNormRes, SchedSimple>(lds, wave, DFF, S, E);
#else
                EpiF32 E{(float*)(ws + WS_MIX), DM};
                pg8::gemm_phase<EpiF32, SchedSimple>(lds, wave, DFF, S, E);
#endif
                }
            } else { PH_ON(128) {
                const int lane = lane_op();
                float* out = ap->out; const float* MIX = (const float*)(ws + WS_MIX);
                const float* gp = ap->in[I_NFPOST] + l * DM; const float* gnext = (l + 1 < DEPTH) ? ap->in[I_NMPRE] + (l + 1) * DM : nullptr;
#if !FUSE_NORM
                for (int m = gw; m < T; m += NGW) resid_norm_row(MIX + (size_t)m * DM, out + (size_t)m * DM, out + (size_t)m * DM, gp, gnext, XN + (size_t)m * DM, lane);
#endif
                if (l + 1 < DEPTH) { convert_weights(ap, l + 1, lds, gw, NGW, wave, lane); __syncthreads(); } }
            }
        }
        if (ph + 1 < hi) { if (hi > 4096) cg::this_grid().sync();
            xcd_barrier(gbar, t0); if constexpr (PROBE_SYNC != 0) xcd_barrier(gbar, t0); }
    }
}

extern "C" void kernel_launch(void* const* d_in, const int* in_sizes, int n_in, void* d_out, int out_size, void* d_ws, size_t ws_size, hipStream_t stream) {
    static int grid = 0;
    if (grid == 0) {
        if (n_in != 26 || in_sizes[0] != T * DM || out_size != T * DM || ws_size < WS_END) {
            fprintf(stderr, "kernel_launch: unexpected problem: n_in %d in0 %d out %d ws %zu (need %zu)\n", n_in, n_in > 0 ? in_sizes[0] : -1, out_size, ws_size, (size_t)WS_END); grid = -1; return; }
        int dev = 0, cus = 0, per_cu = 0;
        hipGetDevice(&dev); hipDeviceGetAttribute(&cus, hipDeviceAttributeMultiprocessorCount, dev);
        if (hipFuncSetAttribute((const void*)fwd_megakernel, hipFuncAttributeMaxDynamicSharedMemorySize, LDS_BYTES) != hipSuccess) { fprintf(stderr, "kernel_launch: hipFuncSetAttribute failed\n"); grid = -1; return; }
        if (hipOccupancyMaxActiveBlocksPerMultiprocessor(&per_cu, (const void*)fwd_megakernel, NTHREADS, LDS_BYTES) != hipSuccess || per_cu < 1) { fprintf(stderr, "kernel_launch: occupancy query says %d\n", per_cu); per_cu = 1; }
        (void)hipGetLastError();
        grid = cus * 1;
        if (FUSE_NORM && grid != 256) { fprintf(stderr, "kernel_launch: the fused norm epilogues need a 256-workgroup grid, got %d\n", grid); grid = -1; return; }
        fprintf(stderr, "kernel_launch: grid %d (cus %d, per_cu %d)\n", grid, cus, per_cu);
    }
    if (grid < 0) return;
    if (hipMemsetAsync(d_ws, 0, CTL_BYTES, stream) != hipSuccess) { fprintf(stderr, "kernel_launch: memset failed\n"); return; }
    Args a{};
    for (int i = 0; i < 26; ++i) a.in[i] = (const float*)d_in[i];
    a.out = (float*)d_out; a.ws = (unsigned char*)d_ws;
#if MK_N_LAUNCHES == 1
    a.lo = 0; a.hi = N_PHASES;
    void* args[] = {&a};
    hipError_t e = hipLaunchCooperativeKernel((const void*)fwd_megakernel, dim3(grid), dim3(NTHREADS), args, LDS_BYTES, stream);
    if (e != hipSuccess) fprintf(stderr, "cooperative launch failed: %s (grid %d)\n", hipGetErrorString(e), grid);
#else
    for (int ph = 0; ph < N_PHASES; ++ph) { a.lo = ph; a.hi = ph + 1; hipLaunchKernelGGL(fwd_megakernel, dim3(grid), dim3(NTHREADS), LDS_BYTES, stream, a); }
#endif
}
```

```cpp
#include <hip/hip_runtime.h>
#include <hip/hip_cooperative_groups.h>
#include <cstdio>
#include <cstdint>
namespace cg = cooperative_groups;

#ifndef MK_N_LAUNCHES
#define MK_N_LAUNCHES 1
#endif

#define LAS __attribute__((address_space(3)))
typedef unsigned short bf16_t;
typedef short bf16x8 __attribute__((ext_vector_type(8)));
typedef float f32x4 __attribute__((ext_vector_type(4)));
typedef float f32x2 __attribute__((ext_vector_type(2)));
typedef float f32x16 __attribute__((ext_vector_type(16)));
typedef unsigned u32x4 __attribute__((ext_vector_type(4)));
typedef unsigned u32x2 __attribute__((ext_vector_type(2)));

constexpr int DM = 1024, NB = 8, SEQ = 2048, DEPTH = 2, T = NB * SEQ, DFF = 4096, WIN = 10240;
constexpr float EPS = 1e-6f, LOG2E = 1.4426950408889634f;
constexpr int NTHREADS = 512, NWAVES = 8;

constexpr size_t MiB = 1u << 20;
constexpr size_t WS_W = 1 * MiB;
constexpr size_t WS_XN = 45 * MiB;
constexpr size_t WS_CA = 77 * MiB;
constexpr size_t WS_AG = 109 * MiB;
constexpr size_t WS_K = 141 * MiB;
constexpr size_t WS_VT = 173 * MiB;
constexpr size_t WS_GEL = 205 * MiB;
constexpr size_t WS_Q = 237 * MiB;
constexpr size_t WS_GU = 269 * MiB;
constexpr size_t WS_STAT = 301 * MiB;
constexpr size_t WS_XBUF = 303 * MiB;
constexpr size_t WS_END = 305 * MiB;
constexpr size_t WS_CNT = 16384;
constexpr size_t CTL_BYTES = 16384 + 8 * 64 * 256;
constexpr size_t WS_GS = WS_AG, WS_SB = WS_K, WS_MIXPRE = WS_GEL;
constexpr size_t WS_MIX = WS_AG;
constexpr size_t WS_H = WS_VT;
constexpr size_t WO_IN = 0, WO_PC = (size_t)WIN * DM, WO_PA = WO_PC + (size_t)DM * DM, WO_PS = WO_PA + (size_t)DM * DM,
                 WO_OUT = WO_PS + (size_t)DM * DM, WO_UP = WO_OUT + (size_t)DM * DM, WO_DOWN = WO_UP + (size_t)DFF * DM;

typedef __bf16 bf16x2_t __attribute__((ext_vector_type(2)));
__device__ __forceinline__ unsigned cvt_pk_bf16(float lo, float hi) { const f32x2 v = {lo, hi}; const bf16x2_t b = __builtin_convertvector(v, bf16x2_t); return __builtin_bit_cast(unsigned, b); }
__device__ __forceinline__ float bf_lo(unsigned u) { return __uint_as_float(u << 16); }
__device__ __forceinline__ float bf_hi(unsigned u) { return __uint_as_float(u & 0xffff0000u); }
__device__ __forceinline__ float fast_sigmoid(float x) { return __builtin_amdgcn_rcpf(1.0f + __builtin_amdgcn_exp2f(-x * LOG2E)); }
__device__ __forceinline__ int lane_id() { return (int)__builtin_amdgcn_mbcnt_hi(~0u, __builtin_amdgcn_mbcnt_lo(~0u, 0u)); }
__device__ __forceinline__ int lane_op() { unsigned z = 0u; asm volatile("" : "+v"(z)); return (int)__builtin_amdgcn_mbcnt_hi(~0u, __builtin_amdgcn_mbcnt_lo(~0u, z)); }
__device__ __forceinline__ float wave_sum(float v) {
    int lid = lane_id(); asm volatile("" : "+v"(lid));
#pragma unroll
    for (int o = 1; o < 64; o <<= 1) v += __int_as_float(__builtin_amdgcn_ds_bpermute((lid ^ o) << 2, __float_as_int(v)));
    return v;
}
__device__ __forceinline__ float swap_add(float v) { auto rr = __builtin_amdgcn_permlane32_swap(__float_as_uint(v), __float_as_uint(v), false, false); return __uint_as_float(rr[0]) + __uint_as_float(rr[1]); }
__device__ __forceinline__ float swap_max(float v) { auto rr = __builtin_amdgcn_permlane32_swap(__float_as_uint(v), __float_as_uint(v), false, false); return fmaxf(__uint_as_float(rr[0]), __uint_as_float(rr[1])); }
__device__ __forceinline__ f32x2 gelu_pk(f32x2 v) {
    const f32x2 av = __builtin_elementwise_abs(v), d = av * 0.2316418882f + 1.0f;
    f32x2 t; t.x = __builtin_amdgcn_rcpf(d.x); t.y = __builtin_amdgcn_rcpf(d.y);
    f32x2 q = t * 0.5307027145f + (-0.7265760135f); q = q * t + 0.7107068705f; q = q * t + (-0.142248368f); q = q * t + 0.127414796f; q = q * t;
    const f32x2 s = (v * v) * (-0.72134752044f);
    f32x2 e; e.x = __builtin_amdgcn_exp2f(s.x); e.y = __builtin_amdgcn_exp2f(s.y);
    const f32x2 m = v * (q * e), r = v - m;
    f32x2 o; o.x = v.x < 0.f ? m.x : r.x; o.y = v.y < 0.f ? m.y : r.y; return o;
}
__device__ __forceinline__ f32x4 gelu4(f32x4 v) { f32x2 a = gelu_pk((f32x2){v[0], v[1]}), b = gelu_pk((f32x2){v[2], v[3]}); return (f32x4){a.x, a.y, b.x, b.y}; }

namespace pg8 {
constexpr int BM = 256, BK = 64, HALF = 128, HTB = HALF * BK * 2, STAGE_BYTES = 8 * HTB, NXCD = 8, WGM = 4;
__host__ __device__ __forceinline__ int lds_byte(int r, int c) { const int st = (r >> 4) * 2 + (c >> 5), rr = r & 15, cc = c & 31, ob = rr * 64 + cc * 2; return st * 1024 + (ob ^ (((ob >> 9) & 1) << 5)); }
__host__ __device__ __forceinline__ void stage_rc(int b, int& R, int& C) { const int st = b / 1024, sb = b % 1024, swz = sb ^ (((sb >> 9) & 1) << 5); R = (st >> 1) * 16 + swz / 64; C = (st & 1) * 32 + (swz % 64) / 2; }
__host__ __device__ __forceinline__ int perm32(int rho) { const int n = rho >> 4, i = rho & 15; return 8 * (i >> 2) + 4 * n + (i & 3); }

struct Unit { int pm, pn, j; };
__device__ __forceinline__ void tile_map(int wgid, int nM, int nN, int& pm, int& pn) {
    const int nwg = nM * nN;
    { const int q = nwg / NXCD, r = nwg % NXCD, xcd = wgid % NXCD, off = wgid / NXCD; wgid = (xcd < r ? xcd * (q + 1) : r * (q + 1) + (xcd - r) * q) + off; }
    const int nig = WGM * nN, gid = wgid / nig, fm = gid * WGM, gsz = (nM - fm) < WGM ? (nM - fm) : WGM;
    pm = fm + ((wgid % nig) % gsz); pn = (wgid % nig) / gsz;
}

template <class Epi, class Sched, bool ALIGN_EPI = true>
__device__ __forceinline__ void gemm_phase(LAS unsigned char* lds, const int wave_s, const int K, const Sched& S, const Epi& E) {
    const int tid_ = wave_s * 64 + lane_op();
    const int tid = tid_, wid = wave_s, lane = tid & 63, wr = wid >> 2, wc = wid & 3, fr = lane & 15, fq = lane >> 4;
    const int nt = K / BK;
    unsigned voffA[2], voffB[2];
#pragma unroll
    for (int i = 0; i < 2; ++i) { int R, C; stage_rc(tid * 16 + i * 8192, R, C); const int Rb = (R & ~31) + perm32(R & 31);
        voffA[i] = (unsigned)(R * K + C) * 2u; voffB[i] = (unsigned)(Rb * K + C) * 2u; }
    const size_t kstep = (size_t)(BK * 2);
    const size_t hstep = (size_t)HALF * K * 2;
    const unsigned ldsw = (unsigned)wid * 1024u;
    const int aoff = lds_byte(wr * 64 + fr, fq * 8), boff = lds_byte(wc * 32 + fr, fq * 8);
#define PG8_SA(b, h) (((b) * 2 + (h)) * HTB)
#define PG8_SB(b, h) ((4 + (b) * 2 + (h)) * HTB)
#define PG8_STAGE(bufoff, gbase, voff) do { _Pragma("unroll") for (int _i = 0; _i < 2; ++_i) \
        __builtin_amdgcn_global_load_lds((const unsigned*)((const char*)(gbase) + (voff)[_i]), (LAS unsigned*)(lds + (bufoff) + ldsw + _i * 8192), 16, 0, 0); } while (0)
#define PG8_LDA(dst, b, h) do { _Pragma("unroll") for (int m = 0; m < 4; ++m) _Pragma("unroll") for (int k = 0; k < 2; ++k) dst[m][k] = *(const LAS bf16x8*)(lds + PG8_SA(b, h) + aoff + m * 2048 + k * 1024); } while (0)
#define PG8_LDB(dst, b, h) do { _Pragma("unroll") for (int n = 0; n < 2; ++n) _Pragma("unroll") for (int k = 0; k < 2; ++k) dst[n][k] = *(const LAS bf16x8*)(lds + PG8_SB(b, h) + boff + n * 2048 + k * 1024); } while (0)
#define PG8_MMA(ai, bj, At, Bt) do { __builtin_amdgcn_s_setprio(1); _Pragma("unroll") for (int m = 0; m < 4; ++m) _Pragma("unroll") for (int n = 0; n < 2; ++n) _Pragma("unroll") for (int k = 0; k < 2; ++k) \
        acc[ai][bj][m][n] = __builtin_amdgcn_mfma_f32_16x16x32_bf16(Bt[n][k], At[m][k], acc[ai][bj][m][n], 0, 0, 0); __builtin_amdgcn_s_setprio(0); } while (0)
#define PG8_WAIT_V(n) asm volatile("s_waitcnt vmcnt(" #n ")" ::: "memory")
#define PG8_WAIT_L(n) asm volatile("s_waitcnt lgkmcnt(" #n ")" ::: "memory")
#define PG8_BAR __builtin_amdgcn_s_barrier()
#define PG8_SCHED __builtin_amdgcn_sched_barrier(0)
    Unit cur, nxt; int ui = 0;
    if (!S.next(0, cur)) return;
    f32x4 acc[2][2][4][2];
#pragma unroll
    for (int a = 0; a < 2; ++a)
#pragma unroll
        for (int b = 0; b < 2; ++b)
#pragma unroll
            for (int m = 0; m < 4; ++m)
#pragma unroll
                for (int n = 0; n < 2; ++n) acc[a][b][m][n] = (f32x4){0.f, 0.f, 0.f, 0.f};
    bf16x8 At[4][2], B0[2][2], B1[2][2];
    const char* cA = S.aptr(cur); const char* cB = S.bptr(cur);
    PG8_STAGE(PG8_SB(0, 0), cB, voffB); PG8_STAGE(PG8_SB(0, 1), cB + hstep, voffB); PG8_STAGE(PG8_SA(0, 0), cA, voffA); PG8_STAGE(PG8_SA(0, 1), cA + hstep, voffA);
    if (wr == 1) PG8_BAR;
    PG8_WAIT_V(2); PG8_BAR;
    PG8_STAGE(PG8_SB(1, 0), cB + kstep, voffB); PG8_STAGE(PG8_SA(1, 0), cA + kstep, voffA); PG8_STAGE(PG8_SB(1, 1), cB + hstep + kstep, voffB);
    PG8_WAIT_V(6); PG8_BAR;
    for (;;) {
        const bool has_next = S.next(ui + 1, nxt);
        const char* nA = has_next ? S.aptr(nxt) : cA; const char* nB = has_next ? S.bptr(nxt) : cB;
        for (int t = 0; t < nt; t += 2) {
            const bool last = (t == nt - 2);
            const char* a1 = cA + (size_t)(t + 1) * kstep;
            const char* a2 = last ? nA : cA + (size_t)(t + 2) * kstep; const char* b2 = last ? nB : cB + (size_t)(t + 2) * kstep;
            const char* a3 = a2 + kstep; const char* b3 = b2 + kstep;
            PG8_LDB(B0, 0, 0); PG8_LDB(B1, 0, 1); PG8_SCHED; PG8_LDA(At, 0, 0); PG8_STAGE(PG8_SA(1, 1), a1 + hstep, voffA);
            PG8_WAIT_V(8); PG8_WAIT_L(0); PG8_BAR; PG8_MMA(0, 0, At, B0); PG8_MMA(0, 1, At, B1); PG8_BAR; PG8_SCHED;
            PG8_LDA(At, 0, 1); PG8_STAGE(PG8_SB(0, 0), b2, voffB); PG8_STAGE(PG8_SB(0, 1), b2 + hstep, voffB); PG8_STAGE(PG8_SA(0, 0), a2, voffA);
            PG8_WAIT_V(8); PG8_WAIT_L(0); PG8_BAR; PG8_MMA(1, 0, At, B0); PG8_MMA(1, 1, At, B1); PG8_BAR; PG8_SCHED;
            PG8_LDB(B0, 1, 0); PG8_LDB(B1, 1, 1); PG8_SCHED; PG8_LDA(At, 1, 0); PG8_STAGE(PG8_SA(0, 1), a2 + hstep, voffA);
            PG8_WAIT_V(8); PG8_WAIT_L(0); PG8_BAR; PG8_MMA(0, 0, At, B0); PG8_MMA(0, 1, At, B1); PG8_BAR; PG8_SCHED;
            PG8_LDA(At, 1, 1); PG8_STAGE(PG8_SB(1, 0), b3, voffB); PG8_STAGE(PG8_SB(1, 1), b3 + hstep, voffB); PG8_STAGE(PG8_SA(1, 0), a3, voffA);
            PG8_WAIT_V(8); PG8_WAIT_L(0); PG8_BAR; PG8_MMA(1, 0, At, B0); PG8_MMA(1, 1, At, B1); PG8_BAR; PG8_SCHED;
        }
        if constexpr (ALIGN_EPI) { if (wr == 0) PG8_BAR; }
        E(acc, cur, wr, wc, fr, fq);
        if (!has_next) break;
#pragma unroll
        for (int a = 0; a < 2; ++a)
#pragma unroll
            for (int b = 0; b < 2; ++b)
#pragma unroll
                for (int m = 0; m < 4; ++m)
#pragma unroll
                    for (int n = 0; n < 2; ++n) acc[a][b][m][n] = (f32x4){0.f, 0.f, 0.f, 0.f};
        cur = nxt; cA = nA; cB = nB; ++ui;
        if constexpr (ALIGN_EPI) { if (wr == 1) PG8_BAR; }
    }
    PG8_WAIT_V(0);
    if constexpr (!ALIGN_EPI) { if (wr == 0) PG8_BAR; }
    PG8_BAR;
#undef PG8_SA
#undef PG8_SB
#undef PG8_STAGE
#undef PG8_LDA
#undef PG8_LDB
#undef PG8_MMA
#undef PG8_WAIT_V
#undef PG8_WAIT_L
#undef PG8_BAR
#undef PG8_SCHED
}
}
using pg8::Unit;

struct SchedSimple {
    const bf16_t* A; const bf16_t* Bt; int nM, nN, K, G, c;
    __device__ __forceinline__ bool next(int i, Unit& u) const { const long L = (long)i * G + c; if (L >= (long)nM * nN) return false; pg8::tile_map((int)L, nM, nN, u.pm, u.pn); u.j = 0; return true; }
    __device__ __forceinline__ const char* aptr(const Unit& u) const { return (const char*)A + (size_t)u.pm * 256 * K * 2; }
    __device__ __forceinline__ const char* bptr(const Unit& u) const { return (const char*)Bt + (size_t)u.pn * 256 * K * 2; }
};
struct SchedIn {
    const bf16_t* XN; const bf16_t* W; int G, c;
    __device__ __forceinline__ bool next(int i, Unit& u) const {
        const int L = i * G + c;
        if (L < 64 * 24) { pg8::tile_map(L, 64, 24, u.pm, u.pn); u.j = 0; return true; }
        const int L1 = L - 64 * 24; if (L1 >= 4 * 64) return false;
        pg8::tile_map(L1, 4, 64, u.pm, u.pn); u.j = 1; return true;
    }
    __device__ __forceinline__ const char* aptr(const Unit& u) const { return u.j == 0 ? (const char*)XN + (size_t)u.pm * 256 * DM * 2 : (const char*)W + (size_t)(6144 + u.pm * 256) * DM * 2; }
    __device__ __forceinline__ const char* bptr(const Unit& u) const { return u.j == 0 ? (const char*)W + (size_t)u.pn * 256 * DM * 2 : (const char*)XN + (size_t)u.pn * 256 * DM * 2; }
};
struct SchedProj {
    const unsigned char* ws; int G, c;
    __device__ __forceinline__ bool next(int i, Unit& u) const { const int L = (i / 6) * G + c; if (L >= 256) return false; pg8::tile_map(L, 64, 4, u.pm, u.pn); u.j = i % 6; return true; }
    __device__ __forceinline__ const char* aptr(const Unit& u) const { const int br = u.j >> 1;
        const size_t off = (u.j & 1) ? (br == 0 ? WS_CA : br == 1 ? WS_Q : WS_GU) : WS_XN; return (const char*)ws + off + (size_t)u.pm * 256 * DM * 2; }
    __device__ __forceinline__ const char* bptr(const Unit& u) const { const int br = u.j >> 1;
        const size_t off = (u.j & 1) ? (WS_W + 2 * (WO_PC + (size_t)br * DM * DM)) : (WS_W + 2 * (WO_IN + (size_t)(7168 + br * 1024) * DM)); return (const char*)ws + off + (size_t)u.pn * 256 * DM * 2; }
};

constexpr float QSCALE = 0.125f * LOG2E;
struct EpiIn {
    bf16_t *AG, *Q, *Kb, *GU, *GEL, *VT; float* STAT;
    __device__ __forceinline__ void operator()(const f32x4 (&acc)[2][2][4][2], const Unit& u, int wr, int wc, int fr, int fq) const {
        const int row0 = u.pm * 256 + wr * 64 + fr;
        if (u.j == 1) {
#pragma unroll
            for (int ai = 0; ai < 2; ++ai)
#pragma unroll
                for (int m = 0; m < 4; ++m) { bf16_t* rowp = VT + (size_t)(row0 + ai * 128 + m * 16) * T + u.pn * 256 + wc * 32 + 16 * (fq >> 1);
#pragma unroll
                    for (int bj = 0; bj < 2; ++bj)
#pragma unroll
                        for (int n = 0; n < 2; ++n) { const f32x4 v = acc[ai][bj][m][n]; u32x2 w; w.x = cvt_pk_bf16(v[0], v[1]); w.y = cvt_pk_bf16(v[2], v[3]);
                            *(u32x2*)(rowp + bj * 128 + 4 * (2 * n + (fq & 1))) = w; } }
            return;
        }
        const int pn = u.pn;
        if (pn < 8) {
            const int col = pn * 128 + wc * 32 + 8 * fq;
#pragma unroll
            for (int ai = 0; ai < 2; ++ai)
#pragma unroll
                for (int m = 0; m < 4; ++m) { f32x4 v0 = acc[ai][0][m][0], v1 = acc[ai][0][m][1]; const f32x4 g0 = acc[ai][1][m][0], g1 = acc[ai][1][m][1];
#pragma unroll
                    for (int i = 0; i < 4; ++i) { v0[i] *= fast_sigmoid(g0[i]); v1[i] *= fast_sigmoid(g1[i]); }
                    u32x4 w; w.x = cvt_pk_bf16(v0[0], v0[1]); w.y = cvt_pk_bf16(v0[2], v0[3]); w.z = cvt_pk_bf16(v1[0], v1[1]); w.w = cvt_pk_bf16(v1[2], v1[3]);
                    *(u32x4*)(AG + (size_t)(row0 + ai * 128 + m * 16) * DM + col) = w; }
            return;
        }
        const int sec = (pn - 8) >> 2;
        bf16_t* base = sec == 0 ? Q : sec == 1 ? Kb : sec == 2 ? GU : GEL;
        const int col = ((pn - 8) & 3) * 256 + wc * 32 + 8 * fq;
        const float sc = sec == 0 ? QSCALE : 1.0f;
#pragma unroll
        for (int ai = 0; ai < 2; ++ai)
#pragma unroll
            for (int m = 0; m < 4; ++m) { bf16_t* rowp = base + (size_t)(row0 + ai * 128 + m * 16) * DM + col; float ps = 0.f, ps2 = 0.f;
#pragma unroll
                for (int bj = 0; bj < 2; ++bj) { f32x4 v0 = acc[ai][bj][m][0], v1 = acc[ai][bj][m][1];
                    if (sec >= 2) { v0 = gelu4(v0); v1 = gelu4(v1); }
                    v0 = v0 * sc; v1 = v1 * sc;
                    if (sec == 3) { ps += (v0[0] + v0[1]) + (v0[2] + v0[3]) + (v1[0] + v1[1]) + (v1[2] + v1[3]);
                        ps2 += (v0[0] * v0[0] + v0[1] * v0[1]) + (v0[2] * v0[2] + v0[3] * v0[3]) + (v1[0] * v1[0] + v1[1] * v1[1]) + (v1[2] * v1[2] + v1[3] * v1[3]); }
                    u32x4 w; w.x = cvt_pk_bf16(v0[0], v0[1]); w.y = cvt_pk_bf16(v0[2], v0[3]); w.z = cvt_pk_bf16(v1[0], v1[1]); w.w = cvt_pk_bf16(v1[2], v1[3]);
                    *(u32x4*)(rowp + bj * 128) = w; }
                if (sec == 3) {
                    const int lid = (fq << 4) | fr;
                    ps += __int_as_float(__builtin_amdgcn_ds_bpermute((lid ^ 16) << 2, __float_as_int(ps))); ps2 += __int_as_float(__builtin_amdgcn_ds_bpermute((lid ^ 16) << 2, __float_as_int(ps2)));
                    ps = swap_add(ps); ps2 = swap_add(ps2);
                    if (fq == 0) *(f32x2*)(STAT + (size_t)(row0 + ai * 128 + m * 16) * 32 + (((pn - 8) & 3) * 4 + wc) * 2) = (f32x2){ps, ps2}; } }
    }
};
struct EpiProj {
    bf16_t* Gs; float* Sb; bf16_t* MIXPRE; const float* bgate;
    __device__ __forceinline__ void operator()(const f32x4 (&acc)[2][2][4][2], const Unit& u, int wr, int wc, int fr, int fq) const {
        const int tile = u.pm * 4 + u.pn, tid = (wr * 4 + wc) * 64 + fq * 16 + fr, br = u.j >> 1;
        const int row0 = u.pm * 256 + wr * 64 + fr, col00 = u.pn * 256 + wc * 32 + 8 * fq;
        if ((u.j & 1) == 0) {
#pragma unroll
            for (int bj = 0; bj < 2; ++bj) { const f32x4 b0 = *(const f32x4*)(bgate + br * 1024 + col00 + bj * 128), b1 = *(const f32x4*)(bgate + br * 1024 + col00 + bj * 128 + 4);
#pragma unroll
                for (int ai = 0; ai < 2; ++ai)
#pragma unroll
                    for (int m = 0; m < 4; ++m) { f32x4 v0 = acc[ai][bj][m][0] + b0, v1 = acc[ai][bj][m][1] + b1;
#pragma unroll
                        for (int i = 0; i < 4; ++i) { v0[i] = fast_sigmoid(v0[i]); v1[i] = fast_sigmoid(v1[i]); }
                        u32x4 w; w.x = cvt_pk_bf16(v0[0], v0[1]); w.y = cvt_pk_bf16(v0[2], v0[3]); w.z = cvt_pk_bf16(v1[0], v1[1]); w.w = cvt_pk_bf16(v1[2], v1[3]);
                        *((u32x4*)Gs + ((size_t)(tile * 16 + (ai * 2 + bj) * 4 + m) * NTHREADS + tid)) = w; } }
            return;
        }
#pragma unroll
        for (int ai = 0; ai < 2; ++ai)
#pragma unroll
            for (int bj = 0; bj < 2; ++bj)
#pragma unroll
                for (int m = 0; m < 4; ++m) {
                    const u32x4 g = *((const u32x4*)Gs + ((size_t)(tile * 16 + (ai * 2 + bj) * 4 + m) * NTHREADS + tid));
                    f32x4 y0 = acc[ai][bj][m][0], y1 = acc[ai][bj][m][1];
                    y0[0] *= bf_lo(g.x); y0[1] *= bf_hi(g.x); y0[2] *= bf_lo(g.y); y0[3] *= bf_hi(g.y);
                    y1[0] *= bf_lo(g.z); y1[1] *= bf_hi(g.z); y1[2] *= bf_lo(g.w); y1[3] *= bf_hi(g.w);
                    u32x4* sp = (u32x4*)Sb + ((size_t)(tile * 16 + (ai * 2 + bj) * 4 + m) * NTHREADS + tid);
                    if (br != 0) { const u32x4 t = *sp;
                        y0[0] += bf_lo(t.x); y0[1] += bf_hi(t.x); y0[2] += bf_lo(t.y); y0[3] += bf_hi(t.y); y1[0] += bf_lo(t.z); y1[1] += bf_hi(t.z); y1[2] += bf_lo(t.w); y1[3] += bf_hi(t.w); }
                    u32x4 w; w.x = cvt_pk_bf16(y0[0], y0[1]); w.y = cvt_pk_bf16(y0[2], y0[3]); w.z = cvt_pk_bf16(y1[0], y1[1]); w.w = cvt_pk_bf16(y1[2], y1[3]);
                    if (br != 2) *sp = w;
                    else {
                        *(u32x4*)(MIXPRE + (size_t)(row0 + ai * 128 + m * 16) * DM + col00 + bj * 128) = w; }
                }
    }
};
struct EpiF32 {
    float* O; int ldc;
    __device__ __forceinline__ void operator()(const f32x4 (&acc)[2][2][4][2], const Unit& u, int wr, int wc, int fr, int fq) const {
        const int row0 = u.pm * 256 + wr * 64 + fr, col0 = u.pn * 256 + wc * 32 + 8 * fq;
#pragma unroll
        for (int ai = 0; ai < 2; ++ai)
#pragma unroll
            for (int m = 0; m < 4; ++m) { float* rowp = O + (size_t)(row0 + ai * 128 + m * 16) * ldc + col0;
#pragma unroll
                for (int bj = 0; bj < 2; ++bj) { *(f32x4*)(rowp + bj * 128) = acc[ai][bj][m][0]; *(f32x4*)(rowp + bj * 128 + 4) = acc[ai][bj][m][1]; } }
    }
};
struct EpiRelu2 {
    bf16_t* O; int ldc;
    __device__ __forceinline__ void operator()(const f32x4 (&acc)[2][2][4][2], const Unit& u, int wr, int wc, int fr, int fq) const {
        const int row0 = u.pm * 256 + wr * 64 + fr, col0 = u.pn * 256 + wc * 32 + 8 * fq;
#pragma unroll
        for (int ai = 0; ai < 2; ++ai)
#pragma unroll
            for (int m = 0; m < 4; ++m) { bf16_t* rowp = O + (size_t)(row0 + ai * 128 + m * 16) * ldc + col0;
#pragma unroll
                for (int bj = 0; bj < 2; ++bj) { f32x4 v0 = acc[ai][bj][m][0], v1 = acc[ai][bj][m][1];
#pragma unroll
                    for (int i = 0; i < 4; ++i) { const float a = fmaxf(v0[i], 0.f), b = fmaxf(v1[i], 0.f); v0[i] = a * a; v1[i] = b * b; }
                    u32x4 w; w.x = cvt_pk_bf16(v0[0], v0[1]); w.y = cvt_pk_bf16(v0[2], v0[3]); w.z = cvt_pk_bf16(v1[0], v1[1]); w.w = cvt_pk_bf16(v1[2], v1[3]);
                    *(u32x4*)(rowp + bj * 128) = w; } }
    }
};


constexpr int EN_P = 135168, EN_S = EN_P + 4096, EN_F = EN_S + 1024;
struct EpiNormRes {
    const float* xin; float* xout; const float* gpost; const float* gnext; bf16_t* XN; float* xbuf; unsigned* cnt; LAS unsigned char* lds;
    __device__ __forceinline__ void exchange(const f32x4 (&acc)[2][2][4][2], const Unit& u, int e, int wr, int wc, int fr, int fq) const {
        LAS float* P = (LAS float*)(lds + EN_P); LAS float* S = (LAS float*)(lds + EN_S); volatile LAS unsigned* FL = (volatile LAS unsigned*)(lds + EN_F);
        const int lid = (fq << 4) | fr, wid = wr * 4 + wc, tid = wid * 64 + lid;
#pragma unroll
        for (int ai = 0; ai < 2; ++ai)
#pragma unroll
            for (int m = 0; m < 4; ++m) { float q = 0.f;
#pragma unroll
                for (int bj = 0; bj < 2; ++bj)
#pragma unroll
                    for (int n = 0; n < 2; ++n) { const f32x4 v = acc[ai][bj][m][n]; q += (v[0] * v[0] + v[1] * v[1]) + (v[2] * v[2] + v[3] * v[3]); }
                q += __int_as_float(__builtin_amdgcn_ds_bpermute((lid ^ 16) << 2, __float_as_int(q))); q = swap_add(q);
                if (fq == 0) P[(ai * 128 + wr * 64 + m * 16 + fr) * 4 + wc] = q; }
        __syncthreads();
        float* xb = xbuf + (size_t)e * T * 4 + (size_t)u.pm * 256 * 4; unsigned* c = cnt + (e * 64 + u.pm) * 64;
        if (tid < 256) { const float tot = (P[tid * 4] + P[tid * 4 + 1]) + (P[tid * 4 + 2] + P[tid * 4 + 3]);
            __hip_atomic_store(xb + tid * 4 + u.pn, tot, __ATOMIC_RELAXED, __HIP_MEMORY_SCOPE_AGENT); }
        asm volatile("s_waitcnt vmcnt(0)" ::: "memory");
        if (tid < 256 && lid == 0) __hip_atomic_fetch_add(c, 1u, __ATOMIC_RELAXED, __HIP_MEMORY_SCOPE_AGENT);
        if (wid == 0) { unsigned sp = 0;
            while ((unsigned)__builtin_amdgcn_readfirstlane((int)__hip_atomic_load(c, __ATOMIC_RELAXED, __HIP_MEMORY_SCOPE_AGENT)) < 16u) { __builtin_amdgcn_s_sleep(2); if (++sp > (1u << 22)) break; }
            __builtin_amdgcn_fence(__ATOMIC_ACQUIRE, "agent");
            if (lid == 0) FL[0] = 1u; }
        asm volatile("s_waitcnt vmcnt(0) lgkmcnt(0)" ::: "memory");
        __syncthreads();
        if (tid < 256) { float t4 = 0.f;
#pragma unroll
            for (int k = 0; k < 4; ++k) t4 += __hip_atomic_load(xb + tid * 4 + k, __ATOMIC_RELAXED, __HIP_MEMORY_SCOPE_AGENT);
            S[tid] = 1.0f / sqrtf(t4 * (1.f / DM) + EPS); }
        __syncthreads();
    }
    __device__ __forceinline__ void operator()(f32x4 (&acc)[2][2][4][2], const Unit& u, int wr, int wc, int fr, int fq) const {
        const LAS float* S = (const LAS float*)(lds + EN_S);
        const int col0 = u.pn * 256 + wc * 32 + 8 * fq;
        exchange(acc, u, 0, wr, wc, fr, fq);
#pragma unroll
        for (int ai = 0; ai < 2; ++ai)
#pragma unroll
            for (int m = 0; m < 4; ++m) { const int rl = ai * 128 + wr * 64 + m * 16 + fr; const float r1 = S[rl]; const size_t off = (size_t)(u.pm * 256 + rl) * DM + col0;
#pragma unroll
                for (int bj = 0; bj < 2; ++bj) { const f32x4 xa = *(const f32x4*)(xin + off + bj * 128), xb = *(const f32x4*)(xin + off + bj * 128 + 4);
                    const f32x4 ga = *(const f32x4*)(gpost + col0 + bj * 128), gb = *(const f32x4*)(gpost + col0 + bj * 128 + 4);
                    const f32x4 v0 = xa + acc[ai][bj][m][0] * r1 * ga, v1 = xb + acc[ai][bj][m][1] * r1 * gb;
                    *(f32x4*)(xout + off + bj * 128) = v0; *(f32x4*)(xout + off + bj * 128 + 4) = v1; acc[ai][bj][m][0] = v0; acc[ai][bj][m][1] = v1; }
                asm volatile("" ::: "memory"); }
        if (gnext) {
            exchange(acc, u, 1, wr, wc, fr, fq);
#pragma unroll
            for (int ai = 0; ai < 2; ++ai)
#pragma unroll
                for (int m = 0; m < 4; ++m) { const int rl = ai * 128 + wr * 64 + m * 16 + fr; const float r2 = S[rl]; const size_t off = (size_t)(u.pm * 256 + rl) * DM + col0;
#pragma unroll
                    for (int bj = 0; bj < 2; ++bj) { const f32x4 ga = *(const f32x4*)(gnext + col0 + bj * 128), gb = *(const f32x4*)(gnext + col0 + bj * 128 + 4);
                        const f32x4 v0 = acc[ai][bj][m][0] * r2 * ga, v1 = acc[ai][bj][m][1] * r2 * gb;
                        u32x4 w; w.x = cvt_pk_bf16(v0[0], v0[1]); w.y = cvt_pk_bf16(v0[2], v0[3]); w.z = cvt_pk_bf16(v1[0], v1[1]); w.w = cvt_pk_bf16(v1[2], v1[3]);
                        *(u32x4*)(XN + off + bj * 128) = w; }
                    asm volatile("" ::: "memory"); }
        }
    }
};

struct Args { const float* in[26]; float* out; unsigned char* ws; int lo, hi; };
enum { I_X = 0, I_NMPRE, I_NMPOST, I_WIN, I_BGATE, I_CONVW, I_CONVB, I_CLNG, I_CLNB, I_LQ1, I_LK1, I_LQ2, I_LK2, I_SUBG, I_SLNG, I_SLNB, I_SGUW, I_SGUB,
       I_WPC, I_WPA, I_WPS, I_WOUT, I_NFPRE, I_NFPOST, I_WUP, I_WDOWN };

__device__ __forceinline__ void transpose_item(const float* W, int ld, int scol, bf16_t* WT, int K, int drow, int k0, LAS float* scr, int lane) {
    float tv[32];
#pragma unroll
    for (int i = 0; i < 32; ++i) tv[i] = W[(size_t)(k0 + 2 * i + (lane >> 5)) * ld + scol + (lane & 31)];
#pragma unroll
    for (int i = 0; i < 32; ++i) scr[(2 * i + (lane >> 5)) * 33 + (lane & 31)] = tv[i];
    asm volatile("s_waitcnt lgkmcnt(0)" ::: "memory");
    const int c = lane & 7;
#pragma unroll
    for (int j = 0; j < 4; ++j) { const int n = (lane >> 3) + 8 * j; const LAS float* s = scr + (8 * c) * 33 + n;
        u32x4 o; o.x = cvt_pk_bf16(s[0 * 33], s[1 * 33]); o.y = cvt_pk_bf16(s[2 * 33], s[3 * 33]); o.z = cvt_pk_bf16(s[4 * 33], s[5 * 33]); o.w = cvt_pk_bf16(s[6 * 33], s[7 * 33]);
        *(u32x4*)(WT + (size_t)(drow + n) * K + k0 + 8 * c) = o; }
    asm volatile("s_waitcnt lgkmcnt(0)" ::: "memory");
}
__device__ __forceinline__ int win_src_col(int rb) {
    if (rb < 16) return (rb & 1) * 1024 + 128 * (rb >> 1);
    if (rb < 32) return rb * 128;
    if (rb < 48) return rb * 128 + 1024;
    if (rb < 56) return 4096 + (rb - 48) * 128;
    return rb * 128;
}
typedef const __attribute__((address_space(4))) Args* CArgsW;
__device__ __forceinline__ void convert_weights(CArgsW a, int layer, LAS unsigned char* lds, int gw, int NGW, int wave, int lane) {
    LAS float* scr = (LAS float*)(lds + wave * 16384);
    bf16_t* W = (bf16_t*)(a->ws + WS_W);
    constexpr int I_IN = 16 * 320, I_SQ = 16 * 32, I_U = 16 * 128, I_D = 64 * 32, NIT = I_IN + 4 * I_SQ + I_U + I_D;
    for (int it = gw; it < NIT; it += NGW) {
        int r = it;
        if (r < I_IN) { const int kb = r / 320, nb = r % 320; transpose_item(a->in[I_WIN] + (size_t)layer * DM * WIN, WIN, win_src_col(nb >> 2) + (nb & 3) * 32, W + WO_IN, DM, nb * 32, kb * 64, scr, lane); continue; }
        r -= I_IN;
        if (r < 4 * I_SQ) { const int w = r / I_SQ, q = r % I_SQ, kb = q / 32, nb = q % 32;
            const float* src = a->in[w == 0 ? I_WPC : w == 1 ? I_WPA : w == 2 ? I_WPS : I_WOUT] + (size_t)layer * DM * DM;
            transpose_item(src, DM, nb * 32, W + WO_PC + (size_t)w * DM * DM, DM, nb * 32, kb * 64, scr, lane); continue; }
        r -= 4 * I_SQ;
        if (r < I_U) { const int kb = r / 128, nb = r % 128; transpose_item(a->in[I_WUP] + (size_t)layer * DM * DFF, DFF, nb * 32, W + WO_UP, DM, nb * 32, kb * 64, scr, lane); continue; }
        r -= I_U;
        { const int kb = r / 32, nb = r % 32; transpose_item(a->in[I_WDOWN] + (size_t)layer * DFF * DM, DM, nb * 32, W + WO_DOWN, DFF, nb * 32, kb * 64, scr, lane); }
    }
}

__device__ __forceinline__ void rms_rows4_to_bf16(const float* x0row, size_t rstride, const float* g, bf16_t* o0row, int lane) {
    f32x4 v[4][4]; float s[4];
#pragma unroll
    for (int r = 0; r < 4; ++r) { const f32x4* xr = (const f32x4*)(x0row + r * rstride) + lane; s[r] = 0.f;
#pragma unroll
        for (int j = 0; j < 4; ++j) v[r][j] = xr[64 * j]; }
#pragma unroll
    for (int r = 0; r < 4; ++r)
#pragma unroll
        for (int j = 0; j < 4; ++j) s[r] += (v[r][j].x * v[r][j].x + v[r][j].y * v[r][j].y) + (v[r][j].z * v[r][j].z + v[r][j].w * v[r][j].w);
    { int lid = lane_id(); asm volatile("" : "+v"(lid));
#pragma unroll
      for (int o = 1; o < 64; o <<= 1)
#pragma unroll
          for (int r = 0; r < 4; ++r) s[r] += __int_as_float(__builtin_amdgcn_ds_bpermute((lid ^ o) << 2, __float_as_int(s[r]))); }
    const f32x4* gr = (const f32x4*)g + lane;
#pragma unroll
    for (int r = 0; r < 4; ++r) { const float rstd = __builtin_amdgcn_rsqf(s[r] * (1.f / DM) + EPS); u32x2* o8 = (u32x2*)(o0row + r * rstride) + lane;
#pragma unroll
        for (int j = 0; j < 4; ++j) { const f32x4 gg = gr[64 * j]; u32x2 w; w.x = cvt_pk_bf16(v[r][j].x * rstd * gg.x, v[r][j].y * rstd * gg.y); w.y = cvt_pk_bf16(v[r][j].z * rstd * gg.z, v[r][j].w * rstd * gg.w); o8[64 * j] = w; } }
}
__device__ __forceinline__ void resid_norm_row(const float* yrow, const float* xin, float* xout, const float* gpost, const float* gnext, bf16_t* xn, int lane) {
    const f32x4* yr = (const f32x4*)yrow + lane; const f32x4* xr = (const f32x4*)xin + lane; const f32x4* gp = (const f32x4*)gpost + lane;
    f32x4 v[4]; float s = 0.f;
#pragma unroll
    for (int j = 0; j < 4; ++j) { v[j] = yr[64 * j]; s += (v[j].x * v[j].x + v[j].y * v[j].y) + (v[j].z * v[j].z + v[j].w * v[j].w); }
    const float rstd = 1.f / sqrtf(wave_sum(s) * (1.f / DM) + EPS);
    float s2 = 0.f;
#pragma unroll
    for (int j = 0; j < 4; ++j) { const f32x4 xx = xr[64 * j], gg = gp[64 * j]; v[j] = xx + v[j] * rstd * gg; s2 += (v[j].x * v[j].x + v[j].y * v[j].y) + (v[j].z * v[j].z + v[j].w * v[j].w); }
    f32x4* xo = (f32x4*)xout + lane;
#pragma unroll
    for (int j = 0; j < 4; ++j) xo[64 * j] = v[j];
    if (gnext) {
        const float r2 = 1.f / sqrtf(wave_sum(s2) * (1.f / DM) + EPS);
        const f32x4* gn = (const f32x4*)gnext + lane; u32x2* o8 = (u32x2*)xn + lane;
#pragma unroll
        for (int j = 0; j < 4; ++j) { const f32x4 gg = gn[64 * j]; u32x2 w; w.x = cvt_pk_bf16(v[j].x * r2 * gg.x, v[j].y * r2 * gg.y); w.y = cvt_pk_bf16(v[j].z * r2 * gg.z, v[j].w * r2 * gg.w); o8[64 * j] = w; }
    }
}

__device__ __forceinline__ void conv_run(LAS unsigned char* lds, const bf16_t* AG, bf16_t* CA, const float* cw, const float* cb, const float* lng, const float* lnb, int unit0, int nun, const int wave_s) {
    const int tid_ = wave_s * 64 + lane_op();
    const int tid = tid_, lane = tid & 63, wid = wave_s;
    const int c = 2 * tid;
    f32x2 in[46]; unsigned nx[16];
    LAS float* red = (LAS float*)lds;
    LAS float* stat = (LAS float*)(lds + 65536);
    const f32x2 bias = *(const f32x2*)(cb + c);
    const f32x2 g = *(const f32x2*)(lng + c), bb = *(const f32x2*)(lnb + c);
    LAS unsigned* wl = (LAS unsigned*)(lds + 65536 + 256);
#pragma unroll
    for (int j = 0; j < 31; ++j) { const f32x2 w = *(const f32x2*)(cw + j * DM + c); wl[j * 512 + tid] = cvt_pk_bf16(w.x, w.y); }
    for (int u = 0; u < nun; ++u) {
        const int tok0 = (unit0 + u) * 16, b = tok0 >> 11, s0 = tok0 & 2047;
        if (u == 0) {
#pragma unroll
            for (int i = 0; i < 46; ++i) { const int s = s0 - 15 + i;
                if (s >= 0 && s < SEQ) { const unsigned v = *(const unsigned*)(AG + (size_t)(b * SEQ + s) * DM + c); in[i] = (f32x2){bf_lo(v), bf_hi(v)}; } else in[i] = (f32x2){0.f, 0.f}; }
        } else {
#pragma unroll
            for (int i = 0; i < 30; ++i) in[i] = in[i + 16];
#pragma unroll
            for (int i = 0; i < 16; ++i) in[30 + i] = (f32x2){bf_lo(nx[i]), bf_hi(nx[i])};
        }
        if (u + 1 < nun) {
#pragma unroll
            for (int i = 0; i < 16; ++i) { const int s = s0 + 31 + i; nx[i] = (s < SEQ) ? *(const unsigned*)(AG + (size_t)(b * SEQ + s) * DM + c) : 0u; }
        }
        f32x2 acc[16];
#pragma unroll
        for (int t = 0; t < 16; ++t) acc[t] = bias;
#pragma unroll
        for (int j = 0; j < 31; ++j) { const unsigned wp = wl[j * 512 + tid]; const f32x2 w = (f32x2){bf_lo(wp), bf_hi(wp)};
#pragma unroll
            for (int t = 0; t < 16; ++t) acc[t] += w * in[t + j]; }
#pragma unroll
        for (int t = 0; t < 16; ++t) { red[(2 * t) * 512 + tid] = acc[t].x + acc[t].y; red[(2 * t + 1) * 512 + tid] = acc[t].x * acc[t].x + acc[t].y * acc[t].y; }
        __syncthreads();
#pragma unroll
        for (int r = 0; r < 2; ++r) { const int tk = wid * 2 + r; float sm = 0.f, sq = 0.f;
#pragma unroll
            for (int i = 0; i < 8; ++i) { sm += red[(2 * tk) * 512 + lane + 64 * i]; sq += red[(2 * tk + 1) * 512 + lane + 64 * i]; }
            sm = wave_sum(sm); sq = wave_sum(sq);
            if (lane == 0) { const float mean = sm * (1.f / DM), var = sq * (1.f / DM) - mean * mean; stat[2 * tk] = mean; stat[2 * tk + 1] = __builtin_amdgcn_rsqf(var + EPS); } }
        __syncthreads();
#pragma unroll
        for (int t = 0; t < 16; ++t) { const float mean = stat[2 * t], rstd = stat[2 * t + 1];
            const float y0 = (acc[t].x - mean) * rstd * g.x + bb.x, y1 = (acc[t].y - mean) * rstd * g.y + bb.y;
            *(unsigned*)(CA + (size_t)(tok0 + t) * DM + c) = cvt_pk_bf16(y0 * fast_sigmoid(y0), y1 * fast_sigmoid(y1)); }
        __syncthreads();
    }
}

constexpr int SG_WL = 0, SG_GL = 128 * 272, SG_ST = 2 * 128 * 272;
template <bool STORE> __device__ __forceinline__ void sgu_unit(LAS unsigned char* lds, const bf16_t* GEL, const float* STAT, bf16_t* GU, const float* sw, const float* sb, const float* lng, const float* lnb, int unit, const int wave_s) {
    const int tid_ = wave_s * 64 + lane_op();
    const int tid = tid_, lane = tid & 63, wid = wave_s;
    const int chunk = unit >> 3, g = unit & 7, tok0 = chunk * 128, c0 = g * 128;
    LAS float* st = (LAS float*)(lds + SG_ST);
    u32x4 gv4[4];
#pragma unroll
    for (int i = 0; i < 4; ++i) { const int id = tid + 512 * i; gv4[i] = *(const u32x4*)(GEL + (size_t)(tok0 + (id >> 4)) * DM + c0 + (id & 15) * 8); }
    if (tid < 128) { const f32x4* sp = (const f32x4*)(STAT + (size_t)(tok0 + tid) * 32); float s = 0.f, s2 = 0.f;
#pragma unroll
        for (int i = 0; i < 8; ++i) { const f32x4 v = sp[i]; s += v[0] + v[2]; s2 += v[1] + v[3]; }
        const float mean = s * (1.f / DM), var = s2 * (1.f / DM) - mean * mean; st[2 * tid] = mean; st[2 * tid + 1] = __builtin_amdgcn_rsqf(var + EPS); }
#pragma unroll
    for (int i = 0; i < 8; ++i) { const int id = tid + 512 * i, t = id >> 5, s4 = (id & 31) * 4; const f32x4 v = *(const f32x4*)(sw + (size_t)g * 16384 + t * 128 + s4);
        u32x2 w; w.x = cvt_pk_bf16(v[0], v[1]); w.y = cvt_pk_bf16(v[2], v[3]); *(LAS u32x2*)(lds + SG_WL + t * 272 + s4 * 2) = w; }
    __syncthreads();
#pragma unroll
    for (int i = 0; i < 4; ++i) { const int id = tid + 512 * i, s = id >> 4, cc = (id & 15) * 8; const u32x4 v = gv4[i];
        const float mean = st[2 * s], rstd = st[2 * s + 1];
        const f32x4 g0 = *(const f32x4*)(lng + c0 + cc), g1 = *(const f32x4*)(lng + c0 + cc + 4), b0 = *(const f32x4*)(lnb + c0 + cc), b1 = *(const f32x4*)(lnb + c0 + cc + 4);
        float x[8] = {bf_lo(v.x), bf_hi(v.x), bf_lo(v.y), bf_hi(v.y), bf_lo(v.z), bf_hi(v.z), bf_lo(v.w), bf_hi(v.w)};
#pragma unroll
        for (int k = 0; k < 8; ++k) { const float gg = k < 4 ? g0[k & 3] : g1[k & 3], bb = k < 4 ? b0[k & 3] : b1[k & 3]; const float y = (x[k] - mean) * rstd * gg + bb;
            *(LAS bf16_t*)(lds + SG_GL + (cc + k) * 272 + s * 2) = (bf16_t)(cvt_pk_bf16(y, 0.f) & 0xffffu); } }
    __syncthreads();
    const int cb = wid & 3, th = wid >> 2, q = lane & 31, hi = lane >> 5;
    f32x16 d0 = {}, d1 = {};
#pragma unroll
    for (int ks = 0; ks < 8; ++ks) {
        const bf16x8 af = *(const LAS bf16x8*)(lds + SG_GL + (32 * cb + q) * 272 + (16 * ks + 8 * hi) * 2);
        const bf16x8 b0 = *(const LAS bf16x8*)(lds + SG_WL + (64 * th + q) * 272 + (16 * ks + 8 * hi) * 2);
        const bf16x8 b1 = *(const LAS bf16x8*)(lds + SG_WL + (64 * th + 32 + q) * 272 + (16 * ks + 8 * hi) * 2);
        d0 = __builtin_amdgcn_mfma_f32_32x32x16_bf16(af, b0, d0, 0, 0, 0);
        d1 = __builtin_amdgcn_mfma_f32_32x32x16_bf16(af, b1, d1, 0, 0, 0);
    }
#pragma unroll
    for (int tb = 0; tb < 2; ++tb) { const int t = 64 * th + 32 * tb + q; const float bias = sb[g * 128 + t];
        bf16_t* rowp = GU + (size_t)(tok0 + t) * DM + c0 + 32 * cb + 4 * hi;
#pragma unroll
        for (int i = 0; i < 4; ++i) { const u32x2 u = *(const u32x2*)(rowp + 8 * i);
            const float m0 = (tb ? d1[4 * i] : d0[4 * i]) + bias, m1 = (tb ? d1[4 * i + 1] : d0[4 * i + 1]) + bias, m2 = (tb ? d1[4 * i + 2] : d0[4 * i + 2]) + bias, m3 = (tb ? d1[4 * i + 3] : d0[4 * i + 3]) + bias;
            u32x2 w; w.x = cvt_pk_bf16(bf_lo(u.x) * m0, bf_hi(u.x) * m1); w.y = cvt_pk_bf16(bf_lo(u.y) * m2, bf_hi(u.y) * m3);
            if (STORE) *(u32x2*)(rowp + 8 * i) = w; } }
    __syncthreads();
}

constexpr int AT_SLOT = 16384, AT_VOFF = 4 * AT_SLOT;
__device__ __forceinline__ float max3f(float a, float b, float c) { return __builtin_fmaxf(__builtin_fmaxf(a, b), c); }
__device__ __forceinline__ void glds16(const void* gsrc, unsigned lds_dst) { unsigned keep;
    asm volatile("s_mov_b32 %0, m0\n\ts_mov_b32 m0, %2\n\ts_nop 0\n\tglobal_load_lds_dwordx4 %1, off\n\ts_mov_b32 m0, %0" : "=&s"(keep) : "v"(gsrc), "s"(lds_dst) : "memory"); }
template <bool STORE> __device__ __forceinline__ void attn_unit(LAS unsigned char* lds, bf16_t* Q, const bf16_t* Kg, const bf16_t* VT, const float* subg, float lam, float outscale, int unit, const int wave_s) {
    const int tid_ = wave_s * 64 + lane_op();
    const int tid = tid_, lane = tid & 63, wid = wave_s, q = lane & 31, hi = lane >> 5;
    const int bh = unit >> 4, qb = unit & 15, b = bh >> 3, h = bh & 7, map = wid >> 2;
    const int qrow0 = qb * 128 + 32 * (wid & 3);
    const int td = qrow0 >> 6;
    bf16x8 qf[4];
    { const bf16_t* Qp = Q + (size_t)(b * SEQ + qrow0 + q) * DM + h * 128 + map * 64 + 8 * hi;
#pragma unroll
      for (int d0 = 0; d0 < 4; ++d0) qf[d0] = *(const bf16x8*)(Qp + 16 * d0); }
    const float sl = __int_as_float(__builtin_amdgcn_readfirstlane(__float_as_int(exp2f(-(float)(h + 1)) * LOG2E)));
    float sself;
    { const bf16_t* Kp = Kg + (size_t)(b * SEQ + qrow0 + q) * DM + h * 128 + map * 64 + 8 * hi; float a = 0.f;
#pragma unroll
      for (int d0 = 0; d0 < 4; ++d0) { const u32x4 kv = *(const u32x4*)(Kp + 16 * d0); const u32x4 qv = __builtin_bit_cast(u32x4, qf[d0]);
#pragma unroll
          for (int j = 0; j < 4; ++j) a += bf_lo(kv[j]) * bf_lo(qv[j]) + bf_hi(kv[j]) * bf_hi(qv[j]); }
      sself = swap_add(a); }
    const unsigned lds0 = (unsigned)(uintptr_t)lds;
    const bf16_t* kgp; const bf16_t* vgp;
    { const int kr = 8 * wid + (lane >> 4), kc = (lane & 15) ^ (kr & 15); kgp = Kg + (size_t)(b * SEQ + kr) * DM + h * 128 + kc * 8;
      const int vr = 16 * wid + (lane >> 3), vc = (lane & 7) ^ ((vr >> 1) & 7); vgp = VT + (size_t)(h * 128 + vr) * T + b * SEQ + vc * 8; }
    const int kx1 = ((((lane & 15) ^ ((8 * wid + (lane >> 4) + 4) & 15)) - ((lane & 15) ^ ((8 * wid + (lane >> 4)) & 15))) * 8) + 4 * DM;
    const int vx1 = ((((lane & 7) ^ (((16 * wid + (lane >> 3) + 8) >> 1) & 7)) - ((lane & 7) ^ (((16 * wid + (lane >> 3)) >> 1) & 7))) * 8) + 8 * T;
    const unsigned kdst = lds0 + wid * 2048, vdst = lds0 + AT_VOFF + wid * 2048;
#define AT_ISSUE_K(tt) do { const unsigned so_ = (unsigned)(((tt) & 3) * AT_SLOT); const bf16_t* kp_ = kgp + (size_t)(tt) * 64 * DM; \
        glds16(kp_, (unsigned)__builtin_amdgcn_readfirstlane(kdst + so_)); glds16(kp_ + kx1, (unsigned)__builtin_amdgcn_readfirstlane(kdst + so_ + 1024)); } while (0)
#define AT_ISSUE_V(tt) do { const unsigned so_ = (unsigned)(((tt) & 3) * AT_SLOT); const bf16_t* vp_ = vgp + (tt) * 64; \
        glds16(vp_, (unsigned)__builtin_amdgcn_readfirstlane(vdst + so_)); glds16(vp_ + vx1, (unsigned)__builtin_amdgcn_readfirstlane(vdst + so_ + 1024)); } while (0)
#define AT_BAR(N) asm volatile("s_waitcnt vmcnt(" #N ") lgkmcnt(0)\n\ts_barrier" ::: "memory")
    AT_ISSUE_K(0); AT_ISSUE_V(0); AT_ISSUE_K(1); AT_ISSUE_V(1); AT_ISSUE_K(2); AT_ISSUE_V(2); AT_ISSUE_K(3);
    AT_BAR(8);
    f32x16 o[4]; o[0] = f32x16{}; o[1] = f32x16{}; o[2] = f32x16{}; o[3] = f32x16{};
    float mref = sself + 6.0f, lsum = 0.f;
    const int koff = q * 256 + (((map * 8 + hi) ^ (q & 15)) << 4), voff = AT_VOFF + q * 128 + ((hi ^ ((q >> 1) & 7)) << 4);
    const float qposf = (float)(qrow0 + q - 4 * hi);
    f32x16 x0, x1, n0, n1;
#define AT_CINIT(tt, sgn, c0, c1) do { const float ss_ = (sgn) * sl, s2_ = ss_ + ss_, s3_ = s2_ + ss_, s4_ = s2_ + s2_, s8_ = s4_ + s4_, s16_ = s8_ + s8_; float g0_ = ss_ * ((float)(64 * (tt)) - qposf) - mref, g1_ = g0_ + (s16_ + s16_); \
        _Pragma("unroll") for (int g = 0; g < 4; ++g) { c0[4 * g] = g0_; c0[4 * g + 1] = g0_ + ss_; c0[4 * g + 2] = g0_ + s2_; c0[4 * g + 3] = g0_ + s3_; \
            c1[4 * g] = g1_; c1[4 * g + 1] = g1_ + ss_; c1[4 * g + 2] = g1_ + s2_; c1[4 * g + 3] = g1_ + s3_; g0_ += s8_; g1_ += s8_; } } while (0)
#define AT_QK(kslot, c0, c1) do { _Pragma("unroll") for (int d0 = 0; d0 < 4; ++d0) { \
        const bf16x8 k0_ = *(const LAS bf16x8*)(lds + (kslot) + (koff ^ (d0 << 5))); const bf16x8 k1_ = *(const LAS bf16x8*)(lds + (kslot) + (koff ^ (d0 << 5)) + 8192); \
        c0 = __builtin_amdgcn_mfma_f32_32x32x16_bf16(k0_, qf[d0], c0, 0, 0, 0); c1 = __builtin_amdgcn_mfma_f32_32x32x16_bf16(k1_, qf[d0], c1, 0, 0, 0); } } while (0)
#define AT_DIAG(tt, c0, c1) do { const float base_ = qposf - (float)(64 * (tt)); \
        _Pragma("unroll") for (int r = 0; r < 16; ++r) { const float cr_ = (float)((r & 3) + 8 * (r >> 2)); c0[r] -= sl * fabsf(base_ - cr_); c1[r] -= sl * fabsf(base_ - 32.f - cr_); } } while (0)
#define AT_MAX(c0, c1, rm) do { float a_ = fmaxf(c0[0], c1[0]), b_ = fmaxf(c0[1], c1[1]); \
        _Pragma("unroll") for (int r = 2; r < 16; r += 2) { a_ = max3f(a_, c0[r], c1[r]); b_ = max3f(b_, c0[r + 1], c1[r + 1]); } rm = swap_max(fmaxf(a_, b_)); } while (0)
    { const float sg0 = td > 0 ? 1.f : 0.f;
      AT_CINIT(0, sg0, x0, x1); AT_QK(0, x0, x1);
      if (td == 0) AT_DIAG(0, x0, x1);
      float rm; AT_MAX(x0, x1, rm);
      if (__any(rm > 8.0f)) { const float dl = fmaxf(rm, 0.f); mref += dl;
#pragma unroll
          for (int r = 0; r < 16; ++r) { x0[r] -= dl; x1[r] -= dl; } } }
    asm volatile("s_waitcnt lgkmcnt(0)\n\ts_barrier" ::: "memory");
#define AT_SB() __builtin_amdgcn_sched_barrier(0)
#define AT_VRD(dst, kk) do { _Pragma("unroll") for (int d = 0; d < 4; ++d) dst[d] = *(const LAS bf16x8*)(lds + vcur_ + (voff ^ ((kk) << 5)) + d * 4096); } while (0)
#define AT_PV(src, kk) do { const bf16x8 pf_ = __builtin_bit_cast(bf16x8, pw_[kk]); _Pragma("unroll") for (int d = 0; d < 4; ++d) o[d] = __builtin_amdgcn_mfma_f32_32x32x16_bf16(src[d], pf_, o[d], 0, 0, 0); } while (0)
#define AT_BODY(MODE, t, SGN, x0, x1, n0, n1) do { \
        const bool pre_ = ((MODE) != 2) && ((t) + 4 < 32); \
        if (pre_) { AT_ISSUE_K((t) + 4); AT_ISSUE_V((t) + 3); } else if (((MODE) != 2) && ((t) + 3 < 32)) { AT_ISSUE_V((t) + 3); } \
        bf16x8 kf_[4], kg_[4], va_[4], vb_[4]; const int ks_ = (((t) + 1) & 3) * AT_SLOT, vcur_ = ((t) & 3) * AT_SLOT; \
        if ((MODE) != 2) { \
            _Pragma("unroll") for (int d0 = 0; d0 < 2; ++d0) { kf_[2 * d0] = *(const LAS bf16x8*)(lds + ks_ + (koff ^ (d0 << 5))); kf_[2 * d0 + 1] = *(const LAS bf16x8*)(lds + ks_ + (koff ^ (d0 << 5)) + 8192); } \
            AT_CINIT((t) + 1, ((MODE) == 1 ? 0.f : (SGN)), n0, n1); } \
        AT_SB(); \
        if ((MODE) != 2) { \
            _Pragma("unroll") for (int d0 = 0; d0 < 2; ++d0) { kg_[2 * d0] = *(const LAS bf16x8*)(lds + ks_ + (koff ^ ((d0 + 2) << 5))); kg_[2 * d0 + 1] = *(const LAS bf16x8*)(lds + ks_ + (koff ^ ((d0 + 2) << 5)) + 8192); } \
            _Pragma("unroll") for (int d0 = 0; d0 < 2; ++d0) { n0 = __builtin_amdgcn_mfma_f32_32x32x16_bf16(kf_[2 * d0], qf[d0], n0, 0, 0, 0); n1 = __builtin_amdgcn_mfma_f32_32x32x16_bf16(kf_[2 * d0 + 1], qf[d0], n1, 0, 0, 0); } \
            _Pragma("unroll") for (int d0 = 0; d0 < 2; ++d0) { n0 = __builtin_amdgcn_mfma_f32_32x32x16_bf16(kg_[2 * d0], qf[d0 + 2], n0, 0, 0, 0); n1 = __builtin_amdgcn_mfma_f32_32x32x16_bf16(kg_[2 * d0 + 1], qf[d0 + 2], n1, 0, 0, 0); } } \
        AT_VRD(va_, 0); \
        float ps_ = 0.f; u32x4 pw_[4]; \
        _Pragma("unroll") for (int r = 0; r < 16; ++r) { x0[r] = __builtin_amdgcn_exp2f(x0[r]); x1[r] = __builtin_amdgcn_exp2f(x1[r]); ps_ += x0[r] + x1[r]; } \
        lsum += ps_; \
        pw_[0].x = cvt_pk_bf16(x0[0], x0[1]); pw_[0].y = cvt_pk_bf16(x0[2], x0[3]); pw_[0].z = cvt_pk_bf16(x0[4], x0[5]); pw_[0].w = cvt_pk_bf16(x0[6], x0[7]); \
        pw_[1].x = cvt_pk_bf16(x0[8], x0[9]); pw_[1].y = cvt_pk_bf16(x0[10], x0[11]); pw_[1].z = cvt_pk_bf16(x0[12], x0[13]); pw_[1].w = cvt_pk_bf16(x0[14], x0[15]); \
        pw_[2].x = cvt_pk_bf16(x1[0], x1[1]); pw_[2].y = cvt_pk_bf16(x1[2], x1[3]); pw_[2].z = cvt_pk_bf16(x1[4], x1[5]); pw_[2].w = cvt_pk_bf16(x1[6], x1[7]); \
        pw_[3].x = cvt_pk_bf16(x1[8], x1[9]); pw_[3].y = cvt_pk_bf16(x1[10], x1[11]); pw_[3].z = cvt_pk_bf16(x1[12], x1[13]); pw_[3].w = cvt_pk_bf16(x1[14], x1[15]); \
        AT_SB(); \
        AT_VRD(vb_, 1); AT_PV(va_, 0); AT_SB(); \
        AT_VRD(va_, 2); AT_PV(vb_, 1); AT_SB(); \
        float rm_ = 0.f; \
        AT_VRD(vb_, 3); AT_PV(va_, 2); \
        if ((MODE) != 2) { if ((MODE) == 1) AT_DIAG((t) + 1, n0, n1); AT_MAX(n0, n1, rm_); } \
        AT_SB(); \
        AT_PV(vb_, 3); \
        if ((MODE) != 2) { \
            if (__any(rm_ > 8.0f)) { const float dl_ = fmaxf(rm_, 0.f); mref += dl_; const float al_ = __builtin_amdgcn_exp2f(-dl_); lsum *= al_; \
                _Pragma("unroll") for (int r = 0; r < 16; ++r) { n0[r] -= dl_; n1[r] -= dl_; } \
                _Pragma("unroll") for (int d = 0; d < 4; ++d) _Pragma("unroll") for (int r = 0; r < 16; ++r) o[d][r] *= al_; } \
            } \
        if (pre_) AT_BAR(8); else AT_BAR(0); } while (0)
    {
        int t = 0;
        for (; t + 2 < td; t += 2) { AT_BODY(0, t, 1.0f, x0, x1, n0, n1); AT_BODY(0, t + 1, 1.0f, n0, n1, x0, x1); }
        if (t + 1 < td) { AT_BODY(0, t, 1.0f, x0, x1, n0, n1); x0 = n0; x1 = n1; ++t; }
        if (td >= 1) { AT_BODY(1, t, 0.0f, x0, x1, n0, n1); x0 = n0; x1 = n1; ++t; }
        for (; t + 1 < 31; t += 2) { AT_BODY(0, t, -1.0f, x0, x1, n0, n1); AT_BODY(0, t + 1, -1.0f, n0, n1, x0, x1); }
        if (t < 31) { AT_BODY(0, t, -1.0f, x0, x1, n0, n1); x0 = n0; x1 = n1; ++t; }
        AT_BODY(2, 31, 0.0f, x0, x1, n0, n1);
    }
#undef AT_BODY
#undef AT_ISSUE_K
#undef AT_ISSUE_V
#undef AT_BAR
#undef AT_SB
#undef AT_VRD
#undef AT_PV
#undef AT_CINIT
#undef AT_QK
#undef AT_DIAG
#undef AT_MAX
    const float inv = 1.0f / swap_add(lsum);
    LAS float* xb = (LAS float*)lds + (wid & 3) * 4096;
    if (map == 1) {
#pragma unroll
        for (int d = 0; d < 4; ++d)
#pragma unroll
            for (int r = 0; r < 16; ++r) xb[(d * 16 + r) * 64 + lane] = o[d][r] * inv;
    }
    __syncthreads();
    if (STORE && map == 0) {
        float ss = 0.f;
#pragma unroll
        for (int d = 0; d < 4; ++d)
#pragma unroll
            for (int r = 0; r < 16; ++r) { const float v = o[d][r] * inv - lam * xb[(d * 16 + r) * 64 + lane]; o[d][r] = v; ss += v * v; }
        ss = swap_add(ss);
        const float rstd = outscale / sqrtf(ss * (1.f / 128.f) + EPS);
        const int l2 = lane_op();
        bf16_t* orow = Q + (size_t)(b * SEQ + qrow0 + (l2 & 31)) * DM + h * 128 + 4 * (l2 >> 5);
#pragma unroll
        for (int d = 0; d < 4; ++d)
#pragma unroll
            for (int i = 0; i < 4; ++i) { const f32x4 gg = *(const f32x4*)(subg + 32 * d + 8 * i + 4 * (l2 >> 5));
                u32x2 w; w.x = cvt_pk_bf16(o[d][4 * i] * rstd * gg[0], o[d][4 * i + 1] * rstd * gg[1]); w.y = cvt_pk_bf16(o[d][4 * i + 2] * rstd * gg[2], o[d][4 * i + 3] * rstd * gg[3]);
                *(u32x2*)(orow + 32 * d + 8 * i) = w; }
    }
    __syncthreads();
}


#define XB_TMO      128
#define XB_XCNT(j)  (256  + 64 * (j))
#define XB_XSUB(j)  (1280 + 64 * (j))
#define XB_XGEN(j)  (2304 + 64 * (j))
#define XB_TOP      3328
#define XB_TOPGEN   3392
#define XCD_BAR_WORDS 3456
#define XB_SPIN_CAP (1u << 22)
__device__ __forceinline__ unsigned xb_ld(unsigned* p)              { return __hip_atomic_load(p, __ATOMIC_RELAXED, __HIP_MEMORY_SCOPE_AGENT); }
__device__ __forceinline__ unsigned xb_add(unsigned* p, unsigned v) { return __hip_atomic_fetch_add(p, v, __ATOMIC_RELAXED, __HIP_MEMORY_SCOPE_AGENT); }
__device__ __forceinline__ unsigned xb_xcc_id() { return (unsigned)__builtin_amdgcn_s_getreg((3 << 11) | 20) & 0xFu; }
#define XB_SPIN(cond, bar) do { unsigned _sp = 0; while (cond) { __builtin_amdgcn_s_sleep(1); \
    if ((++_sp & 255u) == 0u) { if (xb_ld(&(bar)[XB_TMO])) break; if (_sp > XB_SPIN_CAP) { atomicAdd(&(bar)[XB_TMO], 1u); break; } } } } while (0)
struct XcdBarrier { unsigned* bar; unsigned x; volatile LAS unsigned* st; };
__device__ __forceinline__ XcdBarrier xcd_barrier_post(unsigned* bar, volatile LAS unsigned* st, bool t0) {
    XcdBarrier b; b.bar = bar; b.x = xb_xcc_id(); b.st = st;
    if (t0) (void)xb_add(&bar[XB_XCNT(b.x)], 1u);
    return b;
}
__device__ __forceinline__ void xcd_barrier_complete(unsigned* bar, unsigned x, unsigned& nloc, unsigned& nx) {
    const unsigned G = gridDim.x * gridDim.y * gridDim.z;
    unsigned sum, cnt, mine, sp = 0u;
    for (;;) {
        sum = 0u; cnt = 0u; mine = 0u;
#pragma unroll
        for (unsigned j = 0; j < 16; ++j) { const unsigned c = xb_ld(&bar[XB_XCNT(j)]); sum += c; cnt += (c > 0u) ? 1u : 0u; mine = (j == x) ? c : mine; }
        if (sum == G) break;
        __builtin_amdgcn_s_sleep(1);
        if ((++sp & 255u) == 0u) { if (xb_ld(&bar[XB_TMO])) break; if (sp > XB_SPIN_CAP) { atomicAdd(&bar[XB_TMO], 1u); break; } }
    }
    nloc = mine > 0u ? mine : 1u; nx = cnt > 0u ? cnt : 1u;
}
__device__ __forceinline__ void xcd_barrier(const XcdBarrier& b, bool t0) {
    asm volatile("s_waitcnt vmcnt(0)" ::: "memory");
    __syncthreads();
    if (t0) {
        unsigned* bar = b.bar;
        __builtin_amdgcn_s_waitcnt(0);
        unsigned nloc = b.st[0], nx = b.st[1];
        if (nloc == 0u) { xcd_barrier_complete(bar, b.x, nloc, nx); b.st[0] = nloc; b.st[1] = nx; }
        const unsigned old = xb_add(&bar[XB_XSUB(b.x)], 1u);
        const unsigned gen = old / nloc;
        if (old + 1u == (gen + 1u) * nloc) {
            __builtin_amdgcn_fence(__ATOMIC_RELEASE, "agent");
            asm volatile("s_waitcnt vmcnt(0)" ::: "memory");
            const unsigned og = xb_add(&bar[XB_TOP], 1u);
            const unsigned tg = og / nx;
            if (og + 1u == (tg + 1u) * nx) xb_add(&bar[XB_TOPGEN], 1u);
            else XB_SPIN(xb_ld(&bar[XB_TOPGEN]) == tg, bar);
            __builtin_amdgcn_fence(__ATOMIC_ACQUIRE, "agent");
            xb_add(&bar[XB_XGEN(b.x)], 1u);
            asm volatile("s_waitcnt vmcnt(0)" ::: "memory");
        } else {
            XB_SPIN(xb_ld(&bar[XB_XGEN(b.x)]) == gen, bar);
            __builtin_amdgcn_fence(__ATOMIC_ACQUIRE, "agent");
            asm volatile("s_waitcnt vmcnt(0)" ::: "memory");
        }
    }
    __syncthreads();
}

constexpr int LDS_BYTES = 147456;
#ifndef PROBE_GEMM2
#define PROBE_GEMM2 0
#endif
#ifndef FUSE_NORM
#define FUSE_NORM 1
#endif
#if PROBE_GEMM2
constexpr unsigned long long SEQ_PACK = 0x7665543322100ull; constexpr int NPL = 13;
#elif FUSE_NORM
constexpr unsigned long long SEQ_PACK = 0x7653210ull; constexpr int NPL = 7;
#else
constexpr unsigned long long SEQ_PACK = 0x76543210ull; constexpr int NPL = 8;
#endif
constexpr int N_PHASES = 1 + NPL * DEPTH;
#ifndef PROBE_GEMM2
#define PROBE_GEMM2 0
#endif
#ifndef PROBE_SYNC
#define PROBE_SYNC 0
#endif
#ifndef PROBE_CONV2
#define PROBE_CONV2 0
#endif
#ifndef PROBE_P02
#define PROBE_P02 0
#endif
#ifndef PROBE_SGU2
#define PROBE_SGU2 0
#endif
#ifndef PROBE_ATT2
#define PROBE_ATT2 0
#endif
#ifndef PHMASK
#define PHMASK 0xfff
#endif

typedef const __attribute__((address_space(4))) Args* CArgs;
#define PH_ON(bit) if constexpr ((PHMASK & (bit)) != 0)
__global__ void __launch_bounds__(NTHREADS, 2) fwd_megakernel(Args a_unused) {
    extern __shared__ __attribute__((aligned(16))) unsigned char lds_raw[];
    LAS unsigned char* lds = (LAS unsigned char*)lds_raw;
    CArgs ap0 = (CArgs)__builtin_amdgcn_kernarg_segment_ptr();
    const int lo = ap0->lo, hi = ap0->hi;
    const int wave = __builtin_amdgcn_readfirstlane((int)threadIdx.x >> 6);
    const bool t0 = (threadIdx.x == 0);
    volatile LAS unsigned* bst = (volatile LAS unsigned*)(lds + 131072 + 1024);
    if (t0) { bst[0] = 0u; bst[1] = 0u; }
    __syncthreads();
    const XcdBarrier gbar = xcd_barrier_post((unsigned*)ap0->ws, bst, t0);
    for (int ph = lo; ph < hi; ++ph) {
        CArgs ap = ap0; asm volatile("" : "+s"(ap));
        const int G = gridDim.x, bx = blockIdx.x;
        const int vcu = (G % 8 == 0) ? (bx % 8) * (G / 8) + bx / 8 : bx;
        const int gw = vcu * NWAVES + wave, NGW = G * NWAVES;
        unsigned char* ws = ap->ws;
        bf16_t* W = (bf16_t*)(ws + WS_W);
        bf16_t* XN = (bf16_t*)(ws + WS_XN);
        if (ph == 0) { PH_ON(256) { for (int rep_ = 0; rep_ < 1 + PROBE_P02; ++rep_) {
            const int lane = lane_op();
            convert_weights(ap, 0, lds, gw, NGW, wave, lane);
            const float* x = ap->in[I_X]; const float* g = ap->in[I_NMPRE];
            for (int m = gw; m < T; m += 4 * NGW) rms_rows4_to_bf16(x + (size_t)m * DM, (size_t)NGW * DM, g, XN + (size_t)m * DM, lane);
            __syncthreads(); } }
        } else {
            const int l = (ph - 1) / NPL, k = (int)((SEQ_PACK >> (4 * ((ph - 1) % NPL))) & 15ull);
            if (k == 0) { PH_ON(1) {
                SchedIn S{XN, W + WO_IN, G, bx};
                EpiIn E{(bf16_t*)(ws + WS_AG), (bf16_t*)(ws + WS_Q), (bf16_t*)(ws + WS_K), (bf16_t*)(ws + WS_GU), (bf16_t*)(ws + WS_GEL), (bf16_t*)(ws + WS_VT), (float*)(ws + WS_STAT)};
                pg8::gemm_phase<EpiIn, SchedIn>(lds, wave, DM, S, E); }
            } else if (k == 1) { PH_ON(2) {
                const int per = (1024 + G - 1) / G;
                PH_ON(512) {
                    const int lane = lane_op();
                    const float la = wave_sum(ap->in[I_LQ1][l * 64 + lane] * ap->in[I_LK1][l * 64 + lane]), lb = wave_sum(ap->in[I_LQ2][l * 64 + lane] * ap->in[I_LK2][l * 64 + lane]);
                    const float lam_init = 0.8f - 0.6f * expf(-0.3f * (float)l);
                    const float lam = __int_as_float(__builtin_amdgcn_readfirstlane(__float_as_int(expf(la) - expf(lb) + lam_init)));
                    const float oscale = __int_as_float(__builtin_amdgcn_readfirstlane(__float_as_int(1.0f - lam_init)));
                    const float* subg = ap->in[I_SUBG] + l * 128;
                    if constexpr (PROBE_ATT2 != 0) { for (int i = 0; i < per; ++i) { const int u = vcu * per + i; if (u < 1024) attn_unit<false>(lds, (bf16_t*)(ws + WS_Q), (const bf16_t*)(ws + WS_K), (const bf16_t*)(ws + WS_VT), subg, lam, oscale, u, wave); } }
                    for (int i = 0; i < per; ++i) { const int u = vcu * per + i; if (u < 1024) attn_unit<true>(lds, (bf16_t*)(ws + WS_Q), (const bf16_t*)(ws + WS_K), (const bf16_t*)(ws + WS_VT), subg, lam, oscale, u, wave); }
                }
                PH_ON(1024) {
                    const float* cw = ap->in[I_CONVW] + (size_t)l * 31 * DM; const float* cb = ap->in[I_CONVB] + l * DM; const float* lg = ap->in[I_CLNG] + l * DM; const float* lb2 = ap->in[I_CLNB] + l * DM;
                    for (int rep_ = 0; rep_ < 1 + PROBE_CONV2; ++rep_) { const int u0 = vcu * per; int nun = 1024 - u0; nun = nun < 0 ? 0 : (nun > per ? per : nun);
                        if ((128 % per) == 0) conv_run(lds, (const bf16_t*)(ws + WS_AG), (bf16_t*)(ws + WS_CA), cw, cb, lg, lb2, u0, nun, wave);
                        else for (int i = 0; i < nun; ++i) conv_run(lds, (const bf16_t*)(ws + WS_AG), (bf16_t*)(ws + WS_CA), cw, cb, lg, lb2, u0 + i, 1, wave); }
                }
                PH_ON(2048) {
                    const float* sw = ap->in[I_SGUW] + (size_t)l * 8 * 16384; const float* sb = ap->in[I_SGUB] + l * 1024; const float* lg = ap->in[I_SLNG] + l * DM; const float* lb2 = ap->in[I_SLNB] + l * DM;
                    if constexpr (PROBE_SGU2 != 0) { for (int i = 0; i < per; ++i) { const int u = vcu * per + i; if (u < 1024) sgu_unit<false>(lds, (const bf16_t*)(ws + WS_GEL), (const float*)(ws + WS_STAT), (bf16_t*)(ws + WS_GU), sw, sb, lg, lb2, u, wave); } }
                    for (int i = 0; i < per; ++i) { const int u = vcu * per + i; if (u < 1024) sgu_unit<true>(lds, (const bf16_t*)(ws + WS_GEL), (const float*)(ws + WS_STAT), (bf16_t*)(ws + WS_GU), sw, sb, lg, lb2, u, wave); }
                } }
            } else if (k == 2) { PH_ON(4) {
                SchedProj S{ws, G, bx};
                EpiProj E{(bf16_t*)(ws + WS_GS), (float*)(ws + WS_SB), (bf16_t*)(ws + WS_MIXPRE), ap->in[I_BGATE] + l * 3072};
                pg8::gemm_phase<EpiProj, SchedProj>(lds, wave, DM, S, E); }
            } else if (k == 3) { PH_ON(8) {
                SchedSimple S{(const bf16_t*)(ws + WS_MIXPRE), W + WO_OUT, 64, 4, DM, G, bx};
#if FUSE_NORM
                float* out = ap->out;
                EpiNormRes E{(l == 0) ? ap->in[I_X] : out, out, ap->in[I_NMPOST] + l * DM, ap->in[I_NFPRE] + l * DM, XN, (float*)(ws + WS_XBUF) + (size_t)(l * 2 + 0) * 2 * T * 4, (unsigned*)(ws + WS_CNT) + (l * 2 + 0) * 2 * 64 * 64, lds};
                pg8::gemm_phase<EpiNormRes, SchedSimple>(lds, wave, DM, S, E);
#else
                EpiF32 E{(float*)(ws + WS_MIX), DM};
                pg8::gemm_phase<EpiF32, SchedSimple>(lds, wave, DM, S, E);
#endif
                }
            } else if (k == 4) { PH_ON(16) {
                const int lane = lane_op();
                float* out = ap->out; const float* xin = (l == 0) ? ap->in[I_X] : out; const float* MIX = (const float*)(ws + WS_MIX);
                const float* gp = ap->in[I_NMPOST] + l * DM; const float* gn = ap->in[I_NFPRE] + l * DM;
                for (int m = gw; m < T; m += NGW) resid_norm_row(MIX + (size_t)m * DM, xin + (size_t)m * DM, out + (size_t)m * DM, gp, gn, XN + (size_t)m * DM, lane); }
            } else if (k == 5) { PH_ON(32) {
                SchedSimple S{XN, W + WO_UP, 64, 16, DM, G, bx};
                EpiRelu2 E{(bf16_t*)(ws + WS_H), DFF};
                pg8::gemm_phase<EpiRelu2, SchedSimple>(lds, wave, DM, S, E); }
            } else if (k == 6) { PH_ON(64) {
                SchedSimple S{(const bf16_t*)(ws + WS_H), W + WO_DOWN, 64, 4, DFF, G, bx};
#if FUSE_NORM
                float* out = ap->out;
                EpiNormRes E{out, out, ap->in[I_NFPOST] + l * DM, (l + 1 < DEPTH) ? ap->in[I_NMPRE] + (l + 1) * DM : nullptr, XN, (float*)(ws + WS_XBUF) + (size_t)(l * 2 + 1) * 2 * T * 4, (unsigned*)(ws + WS_CNT) + (l * 2 + 1) * 2 * 64 * 64, lds};
                pg8::gemm_phase<EpiNormRes, SchedSimple>(lds, wave, DFF, S, E);
#else
                EpiF32 E{(float*)(ws + WS_MIX), DM};
                pg8::gemm_phase<EpiF32, SchedSimple>(lds, wave, DFF, S, E);
#endif
                }
            } else { PH_ON(128) {
                const int lane = lane_op();
                float* out = ap->out; const float* MIX = (const float*)(ws + WS_MIX);
                const float* gp = ap->in[I_NFPOST] + l * DM; const float* gnext = (l + 1 < DEPTH) ? ap->in[I_NMPRE] + (l + 1) * DM : nullptr;
#if !FUSE_NORM
                for (int m = gw; m < T; m += NGW) resid_norm_row(MIX + (size_t)m * DM, out + (size_t)m * DM, out + (size_t)m * DM, gp, gnext, XN + (size_t)m * DM, lane);
#endif
                if (l + 1 < DEPTH) { convert_weights(ap, l + 1, lds, gw, NGW, wave, lane); __syncthreads(); } }
            }
        }
        if (ph + 1 < hi) { if (hi > 4096) cg::this_grid().sync();
            xcd_barrier(gbar, t0); if constexpr (PROBE_SYNC != 0) xcd_barrier(gbar, t0); }
    }
}

extern "C" void kernel_launch(void* const* d_in, const int* in_sizes, int n_in, void* d_out, int out_size, void* d_ws, size_t ws_size, hipStream_t stream) {
    static int grid = 0;
    if (grid == 0) {
        if (n_in != 26 || in_sizes[0] != T * DM || out_size != T * DM || ws_size < WS_END) {
            fprintf(stderr, "kernel_launch: unexpected problem: n_in %d in0 %d out %d ws %zu (need %zu)\n", n_in, n_in > 0 ? in_sizes[0] : -1, out_size, ws_size, (size_t)WS_END); grid = -1; return; }
        int dev = 0, cus = 0, per_cu = 0;
        hipGetDevice(&dev); hipDeviceGetAttribute(&cus, hipDeviceAttributeMultiprocessorCount, dev);
        if (hipFuncSetAttribute((const void*)fwd_megakernel, hipFuncAttributeMaxDynamicSharedMemorySize, LDS_BYTES) != hipSuccess) { fprintf(stderr, "kernel_launch: hipFuncSetAttribute failed\n"); grid = -1; return; }
        if (hipOccupancyMaxActiveBlocksPerMultiprocessor(&per_cu, (const void*)fwd_megakernel, NTHREADS, LDS_BYTES) != hipSuccess || per_cu < 1) { fprintf(stderr, "kernel_launch: occupancy query says %d\n", per_cu); per_cu = 1; }
        (void)hipGetLastError();
        grid = cus * 1;
        if (FUSE_NORM && grid != 256) { fprintf(stderr, "kernel_launch: the fused norm epilogues need a 256-workgroup grid, got %d\n", grid); grid = -1; return; }
        fprintf(stderr, "kernel_launch: grid %d (cus %d, per_cu %d)\n", grid, cus, per_cu);
    }
    if (grid < 0) return;
    if (hipMemsetAsync(d_ws, 0, CTL_BYTES, stream) != hipSuccess) { fprintf(stderr, "kernel_launch: memset failed\n"); return; }
    Args a{};
    for (int i = 0; i < 26; ++i) a.in[i] = (const float*)d_in[i];
    a.out = (float*)d_out; a.ws = (unsigned char*)d_ws;
#if MK_N_LAUNCHES == 1
    a.lo = 0; a.hi = N_PHASES;
    void* args[] = {&a};
    hipError_t e = hipLaunchCooperativeKernel((const void*)fwd_megakernel, dim3(grid), dim3(NTHREADS), args, LDS_BYTES, stream);
    if (e != hipSuccess) fprintf(stderr, "cooperative launch failed: %s (grid %d)\n", hipGetErrorString(e), grid);
#else
    for (int ph = 0; ph < N_PHASES; ++ph) { a.lo = ph; a.hi = ph + 1; hipLaunchKernelGGL(fwd_megakernel, dim3(grid), dim3(NTHREADS), LDS_BYTES, stream, a); }
#endif
}
```

```cpp
#include <hip/hip_runtime.h>
#include <hip/hip_cooperative_groups.h>
#include <cstdio>
#include <cstdint>
namespace cg = cooperative_groups;

#ifndef MK_N_LAUNCHES
#define MK_N_LAUNCHES 1
#endif

#define LAS __attribute__((address_space(3)))
typedef unsigned short bf16_t;
typedef short bf16x8 __attribute__((ext_vector_type(8)));
typedef float f32x4 __attribute__((ext_vector_type(4)));
typedef float f32x2 __attribute__((ext_vector_type(2)));
typedef float f32x16 __attribute__((ext_vector_type(16)));
typedef unsigned u32x4 __attribute__((ext_vector_type(4)));
typedef unsigned u32x2 __attribute__((ext_vector_type(2)));

constexpr int DM = 1024, NB = 8, SEQ = 2048, DEPTH = 2, T = NB * SEQ, DFF = 4096, WIN = 10240;
constexpr float EPS = 1e-6f, LOG2E = 1.4426950408889634f;
constexpr int NTHREADS = 512, NWAVES = 8;

constexpr size_t MiB = 1u << 20;
constexpr size_t WS_W = 1 * MiB;
constexpr size_t WS_XN = 45 * MiB;
constexpr size_t WS_CA = 77 * MiB;
constexpr size_t WS_AG = 109 * MiB;
constexpr size_t WS_K = 141 * MiB;
constexpr size_t WS_VT = 173 * MiB;
constexpr size_t WS_GEL = 205 * MiB;
constexpr size_t WS_Q = 237 * MiB;
constexpr size_t WS_GU = 269 * MiB;
constexpr size_t WS_STAT = 301 * MiB;
constexpr size_t WS_XBUF = 303 * MiB;
constexpr size_t WS_END = 305 * MiB;
constexpr size_t WS_CNT = 16384;
constexpr size_t CTL_BYTES = 16384 + 8 * 64 * 256;
constexpr size_t WS_GS = WS_AG, WS_SB = WS_K, WS_MIXPRE = WS_GEL;
constexpr size_t WS_MIX = WS_AG;
constexpr size_t WS_H = WS_VT;
constexpr size_t WO_IN = 0, WO_PC = (size_t)WIN * DM, WO_PA = WO_PC + (size_t)DM * DM, WO_PS = WO_PA + (size_t)DM * DM,
                 WO_OUT = WO_PS + (size_t)DM * DM, WO_UP = WO_OUT + (size_t)DM * DM, WO_DOWN = WO_UP + (size_t)DFF * DM;

typedef __bf16 bf16x2_t __attribute__((ext_vector_type(2)));
__device__ __forceinline__ unsigned cvt_pk_bf16(float lo, float hi) { const f32x2 v = {lo, hi}; const bf16x2_t b = __builtin_convertvector(v, bf16x2_t); return __builtin_bit_cast(unsigned, b); }
__device__ __forceinline__ float bf_lo(unsigned u) { return __uint_as_float(u << 16); }
__device__ __forceinline__ float bf_hi(unsigned u) { return __uint_as_float(u & 0xffff0000u); }
__device__ __forceinline__ float fast_sigmoid(float x) { return __builtin_amdgcn_rcpf(1.0f + __builtin_amdgcn_exp2f(-x * LOG2E)); }
__device__ __forceinline__ int lane_id() { return (int)__builtin_amdgcn_mbcnt_hi(~0u, __builtin_amdgcn_mbcnt_lo(~0u, 0u)); }
__device__ __forceinline__ int lane_op() { unsigned z = 0u; asm volatile("" : "+v"(z)); return (int)__builtin_amdgcn_mbcnt_hi(~0u, __builtin_amdgcn_mbcnt_lo(~0u, z)); }
__device__ __forceinline__ float wave_sum(float v) {
    int lid = lane_id(); asm volatile("" : "+v"(lid));
#pragma unroll
    for (int o = 1; o < 64; o <<= 1) v += __int_as_float(__builtin_amdgcn_ds_bpermute((lid ^ o) << 2, __float_as_int(v)));
    return v;
}
__device__ __forceinline__ float swap_add(float v) { auto rr = __builtin_amdgcn_permlane32_swap(__float_as_uint(v), __float_as_uint(v), false, false); return __uint_as_float(rr[0]) + __uint_as_float(rr[1]); }
__device__ __forceinline__ float swap_max(float v) { auto rr = __builtin_amdgcn_permlane32_swap(__float_as_uint(v), __float_as_uint(v), false, false); return fmaxf(__uint_as_float(rr[0]), __uint_as_float(rr[1])); }
__device__ __forceinline__ f32x2 gelu_pk(f32x2 v) {
    const f32x2 av = __builtin_elementwise_abs(v), d = av * 0.2316418882f + 1.0f;
    f32x2 t; t.x = __builtin_amdgcn_rcpf(d.x); t.y = __builtin_amdgcn_rcpf(d.y);
    f32x2 q = t * 0.5307027145f + (-0.7265760135f); q = q * t + 0.7107068705f; q = q * t + (-0.142248368f); q = q * t + 0.127414796f; q = q * t;
    const f32x2 s = (v * v) * (-0.72134752044f);
    f32x2 e; e.x = __builtin_amdgcn_exp2f(s.x); e.y = __builtin_amdgcn_exp2f(s.y);
    const f32x2 m = v * (q * e), r = v - m;
    f32x2 o; o.x = v.x < 0.f ? m.x : r.x; o.y = v.y < 0.f ? m.y : r.y; return o;
}
__device__ __forceinline__ f32x4 gelu4(f32x4 v) { f32x2 a = gelu_pk((f32x2){v[0], v[1]}), b = gelu_pk((f32x2){v[2], v[3]}); return (f32x4){a.x, a.y, b.x, b.y}; }

namespace pg8 {
constexpr int BM = 256, BK = 64, HALF = 128, HTB = HALF * BK * 2, STAGE_BYTES = 8 * HTB, NXCD = 8, WGM = 4;
__host__ __device__ __forceinline__ int lds_byte(int r, int c) { const int st = (r >> 4) * 2 + (c >> 5), rr = r & 15, cc = c & 31, ob = rr * 64 + cc * 2; return st * 1024 + (ob ^ (((ob >> 9) & 1) << 5)); }
__host__ __device__ __forceinline__ void stage_rc(int b, int& R, int& C) { const int st = b / 1024, sb = b % 1024, swz = sb ^ (((sb >> 9) & 1) << 5); R = (st >> 1) * 16 + swz / 64; C = (st & 1) * 32 + (swz % 64) / 2; }
__host__ __device__ __forceinline__ int perm32(int rho) { const int n = rho >> 4, i = rho & 15; return 8 * (i >> 2) + 4 * n + (i & 3); }

struct Unit { int pm, pn, j; };
__device__ __forceinline__ void tile_map(int wgid, int nM, int nN, int& pm, int& pn) {
    const int nwg = nM * nN;
    { const int q = nwg / NXCD, r = nwg % NXCD, xcd = wgid % NXCD, off = wgid / NXCD; wgid = (xcd < r ? xcd * (q + 1) : r * (q + 1) + (xcd - r) * q) + off; }
    const int nig = WGM * nN, gid = wgid / nig, fm = gid * WGM, gsz = (nM - fm) < WGM ? (nM - fm) : WGM;
    pm = fm + ((wgid % nig) % gsz); pn = (wgid % nig) / gsz;
}

template <class Epi, class Sched, bool ALIGN_EPI = true>
__device__ __forceinline__ void gemm_phase(LAS unsigned char* lds, const int wave_s, const int K, const Sched& S, const Epi& E) {
    const int tid_ = wave_s * 64 + lane_op();
    const int tid = tid_, wid = wave_s, lane = tid & 63, wr = wid >> 2, wc = wid & 3, fr = lane & 15, fq = lane >> 4;
    const int nt = K / BK;
    unsigned voffA[2], voffB[2];
#pragma unroll
    for (int i = 0; i < 2; ++i) { int R, C; stage_rc(tid * 16 + i * 8192, R, C); const int Rb = (R & ~31) + perm32(R & 31);
        voffA[i] = (unsigned)(R * K + C) * 2u; voffB[i] = (unsigned)(Rb * K + C) * 2u; }
    const size_t kstep = (size_t)(BK * 2);
    const size_t hstep = (size_t)HALF * K * 2;
    const unsigned ldsw = (unsigned)wid * 1024u;
    const int aoff = lds_byte(wr * 64 + fr, fq * 8), boff = lds_byte(wc * 32 + fr, fq * 8);
#define PG8_SA(b, h) (((b) * 2 + (h)) * HTB)
#define PG8_SB(b, h) ((4 + (b) * 2 + (h)) * HTB)
#define PG8_STAGE(bufoff, gbase, voff) do { _Pragma("unroll") for (int _i = 0; _i < 2; ++_i) \
        __builtin_amdgcn_global_load_lds((const unsigned*)((const char*)(gbase) + (voff)[_i]), (LAS unsigned*)(lds + (bufoff) + ldsw + _i * 8192), 16, 0, 0); } while (0)
#define PG8_LDA(dst, b, h) do { _Pragma("unroll") for (int m = 0; m < 4; ++m) _Pragma("unroll") for (int k = 0; k < 2; ++k) dst[m][k] = *(const LAS bf16x8*)(lds + PG8_SA(b, h) + aoff + m * 2048 + k * 1024); } while (0)
#define PG8_LDB(dst, b, h) do { _Pragma("unroll") for (int n = 0; n < 2; ++n) _Pragma("unroll") for (int k = 0; k < 2; ++k) dst[n][k] = *(const LAS bf16x8*)(lds + PG8_SB(b, h) + boff + n * 2048 + k * 1024); } while (0)
#define PG8_MMA(ai, bj, At, Bt) do { __builtin_amdgcn_s_setprio(1); _Pragma("unroll") for (int m = 0; m < 4; ++m) _Pragma("unroll") for (int n = 0; n < 2; ++n) _Pragma("unroll") for (int k = 0; k < 2; ++k) \
        acc[ai][bj][m][n] = __builtin_amdgcn_mfma_f32_16x16x32_bf16(Bt[n][k], At[m][k], acc[ai][bj][m][n], 0, 0, 0); __builtin_amdgcn_s_setprio(0); } while (0)
#define PG8_WAIT_V(n) asm volatile("s_waitcnt vmcnt(" #n ")" ::: "memory")
#define PG8_WAIT_L(n) asm volatile("s_waitcnt lgkmcnt(" #n ")" ::: "memory")
#define PG8_BAR __builtin_amdgcn_s_barrier()
#define PG8_SCHED __builtin_amdgcn_sched_barrier(0)
    Unit cur, nxt; int ui = 0;
    if (!S.next(0, cur)) return;
    f32x4 acc[2][2][4][2];
#pragma unroll
    for (int a = 0; a < 2; ++a)
#pragma unroll
        for (int b = 0; b < 2; ++b)
#pragma unroll
            for (int m = 0; m < 4; ++m)
#pragma unroll
                for (int n = 0; n < 2; ++n) acc[a][b][m][n] = (f32x4){0.f, 0.f, 0.f, 0.f};
    bf16x8 At[4][2], B0[2][2], B1[2][2];
    const char* cA = S.aptr(cur); const char* cB = S.bptr(cur);
    PG8_STAGE(PG8_SB(0, 0), cB, voffB); PG8_STAGE(PG8_SB(0, 1), cB + hstep, voffB); PG8_STAGE(PG8_SA(0, 0), cA, voffA); PG8_STAGE(PG8_SA(0, 1), cA + hstep, voffA);
    if (wr == 1) PG8_BAR;
    PG8_WAIT_V(2); PG8_BAR;
    PG8_STAGE(PG8_SB(1, 0), cB + kstep, voffB); PG8_STAGE(PG8_SA(1, 0), cA + kstep, voffA); PG8_STAGE(PG8_SB(1, 1), cB + hstep + kstep, voffB);
    PG8_WAIT_V(6); PG8_BAR;
    for (;;) {
        const bool has_next = S.next(ui + 1, nxt);
        const char* nA = has_next ? S.aptr(nxt) : cA; const char* nB = has_next ? S.bptr(nxt) : cB;
        for (int t = 0; t < nt; t += 2) {
            const bool last = (t == nt - 2);
            const char* a1 = cA + (size_t)(t + 1) * kstep;
            const char* a2 = last ? nA : cA + (size_t)(t + 2) * kstep; const char* b2 = last ? nB : cB + (size_t)(t + 2) * kstep;
            const char* a3 = a2 + kstep; const char* b3 = b2 + kstep;
            PG8_LDB(B0, 0, 0); PG8_LDB(B1, 0, 1); PG8_SCHED; PG8_LDA(At, 0, 0); PG8_STAGE(PG8_SA(1, 1), a1 + hstep, voffA);
            PG8_WAIT_V(8); PG8_WAIT_L(0); PG8_BAR; PG8_MMA(0, 0, At, B0); PG8_MMA(0, 1, At, B1); PG8_BAR; PG8_SCHED;
            PG8_LDA(At, 0, 1); PG8_STAGE(PG8_SB(0, 0), b2, voffB); PG8_STAGE(PG8_SB(0, 1), b2 + hstep, voffB); PG8_STAGE(PG8_SA(0, 0), a2, voffA);
            PG8_WAIT_V(8); PG8_WAIT_L(0); PG8_BAR; PG8_MMA(1, 0, At, B0); PG8_MMA(1, 1, At, B1); PG8_BAR; PG8_SCHED;
            PG8_LDB(B0, 1, 0); PG8_LDB(B1, 1, 1); PG8_SCHED; PG8_LDA(At, 1, 0); PG8_STAGE(PG8_SA(0, 1), a2 + hstep, voffA);
            PG8_WAIT_V(8); PG8_WAIT_L(0); PG8_BAR; PG8_MMA(0, 0, At, B0); PG8_MMA(0, 1, At, B1); PG8_BAR; PG8_SCHED;
            PG8_LDA(At, 1, 1); PG8_STAGE(PG8_SB(1, 0), b3, voffB); PG8_STAGE(PG8_SB(1, 1), b3 + hstep, voffB); PG8_STAGE(PG8_SA(1, 0), a3, voffA);
            PG8_WAIT_V(8); PG8_WAIT_L(0); PG8_BAR; PG8_MMA(1, 0, At, B0); PG8_MMA(1, 1, At, B1); PG8_BAR; PG8_SCHED;
        }
        if constexpr (ALIGN_EPI) { if (wr == 0) PG8_BAR; }
        E(acc, cur, wr, wc, fr, fq);
        if (!has_next) break;
#pragma unroll
        for (int a = 0; a < 2; ++a)
#pragma unroll
            for (int b = 0; b < 2; ++b)
#pragma unroll
                for (int m = 0; m < 4; ++m)
#pragma unroll
                    for (int n = 0; n < 2; ++n) acc[a][b][m][n] = (f32x4){0.f, 0.f, 0.f, 0.f};
        cur = nxt; cA = nA; cB = nB; ++ui;
        if constexpr (ALIGN_EPI) { if (wr == 1) PG8_BAR; }
    }
    PG8_WAIT_V(0);
    if constexpr (!ALIGN_EPI) { if (wr == 0) PG8_BAR; }
    PG8_BAR;
#undef PG8_SA
#undef PG8_SB
#undef PG8_STAGE
#undef PG8_LDA
#undef PG8_LDB
#undef PG8_MMA
#undef PG8_WAIT_V
#undef PG8_WAIT_L
#undef PG8_BAR
#undef PG8_SCHED
}
}
using pg8::Unit;

struct SchedSimple {
    const bf16_t* A; const bf16_t* Bt; int nM, nN, K, G, c;
    __device__ __forceinline__ bool next(int i, Unit& u) const { const long L = (long)i * G + c; if (L >= (long)nM * nN) return false; pg8::tile_map((int)L, nM, nN, u.pm, u.pn); u.j = 0; return true; }
    __device__ __forceinline__ const char* aptr(const Unit& u) const { return (const char*)A + (size_t)u.pm * 256 * K * 2; }
    __device__ __forceinline__ const char* bptr(const Unit& u) const { return (const char*)Bt + (size_t)u.pn * 256 * K * 2; }
};
struct SchedIn {
    const bf16_t* XN; const bf16_t* W; int G, c;
    __device__ __forceinline__ bool next(int i, Unit& u) const {
        const int L = i * G + c;
        if (L < 64 * 24) { pg8::tile_map(L, 64, 24, u.pm, u.pn); u.j = 0; return true; }
        const int L1 = L - 64 * 24; if (L1 >= 4 * 64) return false;
        pg8::tile_map(L1, 4, 64, u.pm, u.pn); u.j = 1; return true;
    }
    __device__ __forceinline__ const char* aptr(const Unit& u) const { return u.j == 0 ? (const char*)XN + (size_t)u.pm * 256 * DM * 2 : (const char*)W + (size_t)(6144 + u.pm * 256) * DM * 2; }
    __device__ __forceinline__ const char* bptr(const Unit& u) const { return u.j == 0 ? (const char*)W + (size_t)u.pn * 256 * DM * 2 : (const char*)XN + (size_t)u.pn * 256 * DM * 2; }
};
struct SchedProj {
    const unsigned char* ws; int G, c;
    __device__ __forceinline__ bool next(int i, Unit& u) const { const int L = (i / 6) * G + c; if (L >= 256) return false; pg8::tile_map(L, 64, 4, u.pm, u.pn); u.j = i % 6; return true; }
    __device__ __forceinline__ const char* aptr(const Unit& u) const { const int br = u.j >> 1;
        const size_t off = (u.j & 1) ? (br == 0 ? WS_CA : br == 1 ? WS_Q : WS_GU) : WS_XN; return (const char*)ws + off + (size_t)u.pm * 256 * DM * 2; }
    __device__ __forceinline__ const char* bptr(const Unit& u) const { const int br = u.j >> 1;
        const size_t off = (u.j & 1) ? (WS_W + 2 * (WO_PC + (size_t)br * DM * DM)) : (WS_W + 2 * (WO_IN + (size_t)(7168 + br * 1024) * DM)); return (const char*)ws + off + (size_t)u.pn * 256 * DM * 2; }
};

constexpr float QSCALE = 0.125f * LOG2E;
struct EpiIn {
    bf16_t *AG, *Q, *Kb, *GU, *GEL, *VT; float* STAT;
    __device__ __forceinline__ void operator()(const f32x4 (&acc)[2][2][4][2], const Unit& u, int wr, int wc, int fr, int fq) const {
        const int row0 = u.pm * 256 + wr * 64 + fr;
        if (u.j == 1) {
#pragma unroll
            for (int ai = 0; ai < 2; ++ai)
#pragma unroll
                for (int m = 0; m < 4; ++m) { bf16_t* rowp = VT + (size_t)(row0 + ai * 128 + m * 16) * T + u.pn * 256 + wc * 32 + 16 * (fq >> 1);
#pragma unroll
                    for (int bj = 0; bj < 2; ++bj)
#pragma unroll
                        for (int n = 0; n < 2; ++n) { const f32x4 v = acc[ai][bj][m][n]; u32x2 w; w.x = cvt_pk_bf16(v[0], v[1]); w.y = cvt_pk_bf16(v[2], v[3]);
                            *(u32x2*)(rowp + bj * 128 + 4 * (2 * n + (fq & 1))) = w; } }
            return;
        }
        const int pn = u.pn;
        if (pn < 8) {
            const int col = pn * 128 + wc * 32 + 8 * fq;
#pragma unroll
            for (int ai = 0; ai < 2; ++ai)
#pragma unroll
                for (int m = 0; m < 4; ++m) { f32x4 v0 = acc[ai][0][m][0], v1 = acc[ai][0][m][1]; const f32x4 g0 = acc[ai][1][m][0], g1 = acc[ai][1][m][1];
#pragma unroll
                    for (int i = 0; i < 4; ++i) { v0[i] *= fast_sigmoid(g0[i]); v1[i] *= fast_sigmoid(g1[i]); }
                    u32x4 w; w.x = cvt_pk_bf16(v0[0], v0[1]); w.y = cvt_pk_bf16(v0[2], v0[3]); w.z = cvt_pk_bf16(v1[0], v1[1]); w.w = cvt_pk_bf16(v1[2], v1[3]);
                    *(u32x4*)(AG + (size_t)(row0 + ai * 128 + m * 16) * DM + col) = w; }
            return;
        }
        const int sec = (pn - 8) >> 2;
        bf16_t* base = sec == 0 ? Q : sec == 1 ? Kb : sec == 2 ? GU : GEL;
        const int col = ((pn - 8) & 3) * 256 + wc * 32 + 8 * fq;
        const float sc = sec == 0 ? QSCALE : 1.0f;
#pragma unroll
        for (int ai = 0; ai < 2; ++ai)
#pragma unroll
            for (int m = 0; m < 4; ++m) { bf16_t* rowp = base + (size_t)(row0 + ai * 128 + m * 16) * DM + col; float ps = 0.f, ps2 = 0.f;
#pragma unroll
                for (int bj = 0; bj < 2; ++bj) { f32x4 v0 = acc[ai][bj][m][0], v1 = acc[ai][bj][m][1];
                    if (sec >= 2) { v0 = gelu4(v0); v1 = gelu4(v1); }
                    v0 = v0 * sc; v1 = v1 * sc;
                    if (sec == 3) { ps += (v0[0] + v0[1]) + (v0[2] + v0[3]) + (v1[0] + v1[1]) + (v1[2] + v1[3]);
                        ps2 += (v0[0] * v0[0] + v0[1] * v0[1]) + (v0[2] * v0[2] + v0[3] * v0[3]) + (v1[0] * v1[0] + v1[1] * v1[1]) + (v1[2] * v1[2] + v1[3] * v1[3]); }
                    u32x4 w; w.x = cvt_pk_bf16(v0[0], v0[1]); w.y = cvt_pk_bf16(v0[2], v0[3]); w.z = cvt_pk_bf16(v1[0], v1[1]); w.w = cvt_pk_bf16(v1[2], v1[3]);
                    *(u32x4*)(rowp + bj * 128) = w; }
                if (sec == 3) {
                    const int lid = (fq << 4) | fr;
                    ps += __int_as_float(__builtin_amdgcn_ds_bpermute((lid ^ 16) << 2, __float_as_int(ps))); ps2 += __int_as_float(__builtin_amdgcn_ds_bpermute((lid ^ 16) << 2, __float_as_int(ps2)));
                    ps = swap_add(ps); ps2 = swap_add(ps2);
                    if (fq == 0) *(f32x2*)(STAT + (size_t)(row0 + ai * 128 + m * 16) * 32 + (((pn - 8) & 3) * 4 + wc) * 2) = (f32x2){ps, ps2}; } }
    }
};
struct EpiProj {
    bf16_t* Gs; float* Sb; bf16_t* MIXPRE; const float* bgate;
    __device__ __forceinline__ void operator()(const f32x4 (&acc)[2][2][4][2], const Unit& u, int wr, int wc, int fr, int fq) const {
        const int tile = u.pm * 4 + u.pn, tid = (wr * 4 + wc) * 64 + fq * 16 + fr, br = u.j >> 1;
        const int row0 = u.pm * 256 + wr * 64 + fr, col00 = u.pn * 256 + wc * 32 + 8 * fq;
        if ((u.j & 1) == 0) {
#pragma unroll
            for (int bj = 0; bj < 2; ++bj) { const f32x4 b0 = *(const f32x4*)(bgate + br * 1024 + col00 + bj * 128), b1 = *(const f32x4*)(bgate + br * 1024 + col00 + bj * 128 + 4);
#pragma unroll
                for (int ai = 0; ai < 2; ++ai)
#pragma unroll
                    for (int m = 0; m < 4; ++m) { f32x4 v0 = acc[ai][bj][m][0] + b0, v1 = acc[ai][bj][m][1] + b1;
#pragma unroll
                        for (int i = 0; i < 4; ++i) { v0[i] = fast_sigmoid(v0[i]); v1[i] = fast_sigmoid(v1[i]); }
                        u32x4 w; w.x = cvt_pk_bf16(v0[0], v0[1]); w.y = cvt_pk_bf16(v0[2], v0[3]); w.z = cvt_pk_bf16(v1[0], v1[1]); w.w = cvt_pk_bf16(v1[2], v1[3]);
                        *((u32x4*)Gs + ((size_t)(tile * 16 + (ai * 2 + bj) * 4 + m) * NTHREADS + tid)) = w; } }
            return;
        }
#pragma unroll
        for (int ai = 0; ai < 2; ++ai)
#pragma unroll
            for (int bj = 0; bj < 2; ++bj)
#pragma unroll
                for (int m = 0; m < 4; ++m) {
                    const u32x4 g = *((const u32x4*)Gs + ((size_t)(tile * 16 + (ai * 2 + bj) * 4 + m) * NTHREADS + tid));
                    f32x4 y0 = acc[ai][bj][m][0], y1 = acc[ai][bj][m][1];
                    y0[0] *= bf_lo(g.x); y0[1] *= bf_hi(g.x); y0[2] *= bf_lo(g.y); y0[3] *= bf_hi(g.y);
                    y1[0] *= bf_lo(g.z); y1[1] *= bf_hi(g.z); y1[2] *= bf_lo(g.w); y1[3] *= bf_hi(g.w);
                    u32x4* sp = (u32x4*)Sb + ((size_t)(tile * 16 + (ai * 2 + bj) * 4 + m) * NTHREADS + tid);
                    if (br != 0) { const u32x4 t = *sp;
                        y0[0] += bf_lo(t.x); y0[1] += bf_hi(t.x); y0[2] += bf_lo(t.y); y0[3] += bf_hi(t.y); y1[0] += bf_lo(t.z); y1[1] += bf_hi(t.z); y1[2] += bf_lo(t.w); y1[3] += bf_hi(t.w); }
                    u32x4 w; w.x = cvt_pk_bf16(y0[0], y0[1]); w.y = cvt_pk_bf16(y0[2], y0[3]); w.z = cvt_pk_bf16(y1[0], y1[1]); w.w = cvt_pk_bf16(y1[2], y1[3]);
                    if (br != 2) *sp = w;
                    else {
                        *(u32x4*)(MIXPRE + (size_t)(row0 + ai * 128 + m * 16) * DM + col00 + bj * 128) = w; }
                }
    }
};
struct EpiF32 {
    float* O; int ldc;
    __device__ __forceinline__ void operator()(const f32x4 (&acc)[2][2][4][2], const Unit& u, int wr, int wc, int fr, int fq) const {
        const int row0 = u.pm * 256 + wr * 64 + fr, col0 = u.pn * 256 + wc * 32 + 8 * fq;
#pragma unroll
        for (int ai = 0; ai < 2; ++ai)
#pragma unroll
            for (int m = 0; m < 4; ++m) { float* rowp = O + (size_t)(row0 + ai * 128 + m * 16) * ldc + col0;
#pragma unroll
                for (int bj = 0; bj < 2; ++bj) { *(f32x4*)(rowp + bj * 128) = acc[ai][bj][m][0]; *(f32x4*)(rowp + bj * 128 + 4) = acc[ai][bj][m][1]; } }
    }
};
struct EpiRelu2 {
    bf16_t* O; int ldc;
    __device__ __forceinline__ void operator()(const f32x4 (&acc)[2][2][4][2], const Unit& u, int wr, int wc, int fr, int fq) const {
        const int row0 = u.pm * 256 + wr * 64 + fr, col0 = u.pn * 256 + wc * 32 + 8 * fq;
#pragma unroll
        for (int ai = 0; ai < 2; ++ai)
#pragma unroll
            for (int m = 0; m < 4; ++m) { bf16_t* rowp = O + (size_t)(row0 + ai * 128 + m * 16) * ldc + col0;
#pragma unroll
                for (int bj = 0; bj < 2; ++bj) { f32x4 v0 = acc[ai][bj][m][0], v1 = acc[ai][bj][m][1];
#pragma unroll
                    for (int i = 0; i < 4; ++i) { const float a = fmaxf(v0[i], 0.f), b = fmaxf(v1[i], 0.f); v0[i] = a * a; v1[i] = b * b; }
                    u32x4 w; w.x = cvt_pk_bf16(v0[0], v0[1]); w.y = cvt_pk_bf16(v0[2], v0[3]); w.z = cvt_pk_bf16(v1[0], v1[1]); w.w = cvt_pk_bf16(v1[2], v1[3]);
                    *(u32x4*)(rowp + bj * 128) = w; } }
    }
};


constexpr int EN_P = 135168, EN_S = EN_P + 4096, EN_F = EN_S + 1024;
struct EpiNormRes {
    const float* xin; float* xout; const float* gpost; const float* gnext; bf16_t* XN; float* xbuf; unsigned* cnt; LAS unsigned char* lds;
    __device__ __forceinline__ void exchange(const f32x4 (&acc)[2][2][4][2], const Unit& u, int e, int wr, int wc, int fr, int fq) const {
        LAS float* P = (LAS float*)(lds + EN_P); LAS float* S = (LAS float*)(lds + EN_S); volatile LAS unsigned* FL = (volatile LAS unsigned*)(lds + EN_F);
        const int lid = (fq << 4) | fr, wid = wr * 4 + wc, tid = wid * 64 + lid;
#pragma unroll
        for (int ai = 0; ai < 2; ++ai)
#pragma unroll
            for (int m = 0; m < 4; ++m) { float q = 0.f;
#pragma unroll
                for (int bj = 0; bj < 2; ++bj)
#pragma unroll
                    for (int n = 0; n < 2; ++n) { const f32x4 v = acc[ai][bj][m][n]; q += (v[0] * v[0] + v[1] * v[1]) + (v[2] * v[2] + v[3] * v[3]); }
                q += __int_as_float(__builtin_amdgcn_ds_bpermute((lid ^ 16) << 2, __float_as_int(q))); q = swap_add(q);
                if (fq == 0) P[(ai * 128 + wr * 64 + m * 16 + fr) * 4 + wc] = q; }
        __syncthreads();
        float* xb = xbuf + (size_t)e * T * 4 + (size_t)u.pm * 256 * 4; unsigned* c = cnt + (e * 64 + u.pm) * 64;
        if (tid < 256) { const float tot = (P[tid * 4] + P[tid * 4 + 1]) + (P[tid * 4 + 2] + P[tid * 4 + 3]);
            __hip_atomic_store(xb + tid * 4 + u.pn, tot, __ATOMIC_RELAXED, __HIP_MEMORY_SCOPE_AGENT); }
        asm volatile("s_waitcnt vmcnt(0)" ::: "memory");
        if (tid < 256 && lid == 0) __hip_atomic_fetch_add(c, 1u, __ATOMIC_RELAXED, __HIP_MEMORY_SCOPE_AGENT);
        if (wid == 0) { unsigned sp = 0;
            while ((unsigned)__builtin_amdgcn_readfirstlane((int)__hip_atomic_load(c, __ATOMIC_RELAXED, __HIP_MEMORY_SCOPE_AGENT)) < 16u) { __builtin_amdgcn_s_sleep(2); if (++sp > (1u << 22)) break; }
            __builtin_amdgcn_fence(__ATOMIC_ACQUIRE, "agent");
            if (lid == 0) FL[0] = 1u; }
        asm volatile("s_waitcnt vmcnt(0) lgkmcnt(0)" ::: "memory");
        __syncthreads();
        if (tid < 256) { float t4 = 0.f;
#pragma unroll
            for (int k = 0; k < 4; ++k) t4 += __hip_atomic_load(xb + tid * 4 + k, __ATOMIC_RELAXED, __HIP_MEMORY_SCOPE_AGENT);
            S[tid] = 1.0f / sqrtf(t4 * (1.f / DM) + EPS); }
        __syncthreads();
    }
    __device__ __forceinline__ void operator()(f32x4 (&acc)[2][2][4][2], const Unit& u, int wr, int wc, int fr, int fq) const {
        const LAS float* S = (const LAS float*)(lds + EN_S);
        const int col0 = u.pn * 256 + wc * 32 + 8 * fq;
        exchange(acc, u, 0, wr, wc, fr, fq);
#pragma unroll
        for (int ai = 0; ai < 2; ++ai)
#pragma unroll
            for (int m = 0; m < 4; ++m) { const int rl = ai * 128 + wr * 64 + m * 16 + fr; const float r1 = S[rl]; const size_t off = (size_t)(u.pm * 256 + rl) * DM + col0;
#pragma unroll
                for (int bj = 0; bj < 2; ++bj) { const f32x4 xa = *(const f32x4*)(xin + off + bj * 128), xb = *(const f32x4*)(xin + off + bj * 128 + 4);
                    const f32x4 ga = *(const f32x4*)(gpost + col0 + bj * 128), gb = *(const f32x4*)(gpost + col0 + bj * 128 + 4);
                    const f32x4 v0 = xa + acc[ai][bj][m][0] * r1 * ga, v1 = xb + acc[ai][bj][m][1] * r1 * gb;
                    *(f32x4*)(xout + off + bj * 128) = v0; *(f32x4*)(xout + off + bj * 128 + 4) = v1; acc[ai][bj][m][0] = v0; acc[ai][bj][m][1] = v1; }
                asm volatile("" ::: "memory"); }
        if (gnext) {
            exchange(acc, u, 1, wr, wc, fr, fq);
#pragma unroll
            for (int ai = 0; ai < 2; ++ai)
#pragma unroll
                for (int m = 0; m < 4; ++m) { const int rl = ai * 128 + wr * 64 + m * 16 + fr; const float r2 = S[rl]; const size_t off = (size_t)(u.pm * 256 + rl) * DM + col0;
#pragma unroll
                    for (int bj = 0; bj < 2; ++bj) { const f32x4 ga = *(const f32x4*)(gnext + col0 + bj * 128), gb = *(const f32x4*)(gnext + col0 + bj * 128 + 4);
                        const f32x4 v0 = acc[ai][bj][m][0] * r2 * ga, v1 = acc[ai][bj][m][1] * r2 * gb;
                        u32x4 w; w.x = cvt_pk_bf16(v0[0], v0[1]); w.y = cvt_pk_bf16(v0[2], v0[3]); w.z = cvt_pk_bf16(v1[0], v1[1]); w.w = cvt_pk_bf16(v1[2], v1[3]);
                        *(u32x4*)(XN + off + bj * 128) = w; }
                    asm volatile("" ::: "memory"); }
        }
    }
};

struct Args { const float* in[26]; float* out; unsigned char* ws; int lo, hi; };
enum { I_X = 0, I_NMPRE, I_NMPOST, I_WIN, I_BGATE, I_CONVW, I_CONVB, I_CLNG, I_CLNB, I_LQ1, I_LK1, I_LQ2, I_LK2, I_SUBG, I_SLNG, I_SLNB, I_SGUW, I_SGUB,
       I_WPC, I_WPA, I_WPS, I_WOUT, I_NFPRE, I_NFPOST, I_WUP, I_WDOWN };

__device__ __forceinline__ void transpose_item(const float* W, int ld, int scol, bf16_t* WT, int K, int drow, int k0, LAS float* scr, int lane) {
    float tv[32];
#pragma unroll
    for (int i = 0; i < 32; ++i) tv[i] = W[(size_t)(k0 + 2 * i + (lane >> 5)) * ld + scol + (lane & 31)];
#pragma unroll
    for (int i = 0; i < 32; ++i) scr[(2 * i + (lane >> 5)) * 33 + (lane & 31)] = tv[i];
    asm volatile("s_waitcnt lgkmcnt(0)" ::: "memory");
    const int c = lane & 7;
#pragma unroll
    for (int j = 0; j < 4; ++j) { const int n = (lane >> 3) + 8 * j; const LAS float* s = scr + (8 * c) * 33 + n;
        u32x4 o; o.x = cvt_pk_bf16(s[0 * 33], s[1 * 33]); o.y = cvt_pk_bf16(s[2 * 33], s[3 * 33]); o.z = cvt_pk_bf16(s[4 * 33], s[5 * 33]); o.w = cvt_pk_bf16(s[6 * 33], s[7 * 33]);
        *(u32x4*)(WT + (size_t)(drow + n) * K + k0 + 8 * c) = o; }
    asm volatile("s_waitcnt lgkmcnt(0)" ::: "memory");
}
__device__ __forceinline__ int win_src_col(int rb) {
    if (rb < 16) return (rb & 1) * 1024 + 128 * (rb >> 1);
    if (rb < 32) return rb * 128;
    if (rb < 48) return rb * 128 + 1024;
    if (rb < 56) return 4096 + (rb - 48) * 128;
    return rb * 128;
}
typedef const __attribute__((address_space(4))) Args* CArgsW;
__device__ __forceinline__ void convert_weights(CArgsW a, int layer, LAS unsigned char* lds, int gw, int NGW, int wave, int lane) {
    LAS float* scr = (LAS float*)(lds + wave * 16384);
    bf16_t* W = (bf16_t*)(a->ws + WS_W);
    constexpr int I_IN = 16 * 320, I_SQ = 16 * 32, I_U = 16 * 128, I_D = 64 * 32, NIT = I_IN + 4 * I_SQ + I_U + I_D;
    for (int it = gw; it < NIT; it += NGW) {
        int r = it;
        if (r < I_IN) { const int kb = r / 320, nb = r % 320; transpose_item(a->in[I_WIN] + (size_t)layer * DM * WIN, WIN, win_src_col(nb >> 2) + (nb & 3) * 32, W + WO_IN, DM, nb * 32, kb * 64, scr, lane); continue; }
        r -= I_IN;
        if (r < 4 * I_SQ) { const int w = r / I_SQ, q = r % I_SQ, kb = q / 32, nb = q % 32;
            const float* src = a->in[w == 0 ? I_WPC : w == 1 ? I_WPA : w == 2 ? I_WPS : I_WOUT] + (size_t)layer * DM * DM;
            transpose_item(src, DM, nb * 32, W + WO_PC + (size_t)w * DM * DM, DM, nb * 32, kb * 64, scr, lane); continue; }
        r -= 4 * I_SQ;
        if (r < I_U) { const int kb = r / 128, nb = r % 128; transpose_item(a->in[I_WUP] + (size_t)layer * DM * DFF, DFF, nb * 32, W + WO_UP, DM, nb * 32, kb * 64, scr, lane); continue; }
        r -= I_U;
        { const int kb = r / 32, nb = r % 32; transpose_item(a->in[I_WDOWN] + (size_t)layer * DFF * DM, DM, nb * 32, W + WO_DOWN, DFF, nb * 32, kb * 64, scr, lane); }
    }
}

__device__ __forceinline__ void rms_rows4_to_bf16(const float* x0row, size_t rstride, const float* g, bf16_t* o0row, int lane) {
    f32x4 v[4][4]; float s[4];
#pragma unroll
    for (int r = 0; r < 4; ++r) { const f32x4* xr = (const f32x4*)(x0row + r * rstride) + lane; s[r] = 0.f;
#pragma unroll
        for (int j = 0; j < 4; ++j) v[r][j] = xr[64 * j]; }
#pragma unroll
    for (int r = 0; r < 4; ++r)
#pragma unroll
        for (int j = 0; j < 4; ++j) s[r] += (v[r][j].x * v[r][j].x + v[r][j].y * v[r][j].y) + (v[r][j].z * v[r][j].z + v[r][j].w * v[r][j].w);
    { int lid = lane_id(); asm volatile("" : "+v"(lid));
#pragma unroll
      for (int o = 1; o < 64; o <<= 1)
#pragma unroll
          for (int r = 0; r < 4; ++r) s[r] += __int_as_float(__builtin_amdgcn_ds_bpermute((lid ^ o) << 2, __float_as_int(s[r]))); }
    const f32x4* gr = (const f32x4*)g + lane;
#pragma unroll
    for (int r = 0; r < 4; ++r) { const float rstd = __builtin_amdgcn_rsqf(s[r] * (1.f / DM) + EPS); u32x2* o8 = (u32x2*)(o0row + r * rstride) + lane;
#pragma unroll
        for (int j = 0; j < 4; ++j) { const f32x4 gg = gr[64 * j]; u32x2 w; w.x = cvt_pk_bf16(v[r][j].x * rstd * gg.x, v[r][j].y * rstd * gg.y); w.y = cvt_pk_bf16(v[r][j].z * rstd * gg.z, v[r][j].w * rstd * gg.w); o8[64 * j] = w; } }
}
__device__ __forceinline__ void resid_norm_row(const float* yrow, const float* xin, float* xout, const float* gpost, const float* gnext, bf16_t* xn, int lane) {
    const f32x4* yr = (const f32x4*)yrow + lane; const f32x4* xr = (const f32x4*)xin + lane; const f32x4* gp = (const f32x4*)gpost + lane;
    f32x4 v[4]; float s = 0.f;
#pragma unroll
    for (int j = 0; j < 4; ++j) { v[j] = yr[64 * j]; s += (v[j].x * v[j].x + v[j].y * v[j].y) + (v[j].z * v[j].z + v[j].w * v[j].w); }
    const float rstd = 1.f / sqrtf(wave_sum(s) * (1.f / DM) + EPS);
    float s2 = 0.f;
#pragma unroll
    for (int j = 0; j < 4; ++j) { const f32x4 xx = xr[64 * j], gg = gp[64 * j]; v[j] = xx + v[j] * rstd * gg; s2 += (v[j].x * v[j].x + v[j].y * v[j].y) + (v[j].z * v[j].z + v[j].w * v[j].w); }
    f32x4* xo = (f32x4*)xout + lane;
#pragma unroll
    for (int j = 0; j < 4; ++j) xo[64 * j] = v[j];
    if (gnext) {
        const float r2 = 1.f / sqrtf(wave_sum(s2) * (1.f / DM) + EPS);
        const f32x4* gn = (const f32x4*)gnext + lane; u32x2* o8 = (u32x2*)xn + lane;
#pragma unroll
        for (int j = 0; j < 4; ++j) { const f32x4 gg = gn[64 * j]; u32x2 w; w.x = cvt_pk_bf16(v[j].x * r2 * gg.x, v[j].y * r2 * gg.y); w.y = cvt_pk_bf16(v[j].z * r2 * gg.z, v[j].w * r2 * gg.w); o8[64 * j] = w; }
    }
}

__device__ __forceinline__ void conv_run(LAS unsigned char* lds, const bf16_t* AG, bf16_t* CA, const float* cw, const float* cb, const float* lng, const float* lnb, int unit0, int nun, const int wave_s) {
    const int tid_ = wave_s * 64 + lane_op();
    const int tid = tid_, lane = tid & 63, wid = wave_s;
    const int c = 2 * tid;
    f32x2 in[46]; unsigned nx[16];
    LAS float* red = (LAS float*)lds;
    LAS float* stat = (LAS float*)(lds + 65536);
    const f32x2 bias = *(const f32x2*)(cb + c);
    const f32x2 g = *(const f32x2*)(lng + c), bb = *(const f32x2*)(lnb + c);
    LAS unsigned* wl = (LAS unsigned*)(lds + 65536 + 256);
#pragma unroll
    for (int j = 0; j < 31; ++j) { const f32x2 w = *(const f32x2*)(cw + j * DM + c); wl[j * 512 + tid] = cvt_pk_bf16(w.x, w.y); }
    for (int u = 0; u < nun; ++u) {
        const int tok0 = (unit0 + u) * 16, b = tok0 >> 11, s0 = tok0 & 2047;
        if (u == 0) {
#pragma unroll
            for (int i = 0; i < 46; ++i) { const int s = s0 - 15 + i;
                if (s >= 0 && s < SEQ) { const unsigned v = *(const unsigned*)(AG + (size_t)(b * SEQ + s) * DM + c); in[i] = (f32x2){bf_lo(v), bf_hi(v)}; } else in[i] = (f32x2){0.f, 0.f}; }
        } else {
#pragma unroll
            for (int i = 0; i < 30; ++i) in[i] = in[i + 16];
#pragma unroll
            for (int i = 0; i < 16; ++i) in[30 + i] = (f32x2){bf_lo(nx[i]), bf_hi(nx[i])};
        }
        if (u + 1 < nun) {
#pragma unroll
            for (int i = 0; i < 16; ++i) { const int s = s0 + 31 + i; nx[i] = (s < SEQ) ? *(const unsigned*)(AG + (size_t)(b * SEQ + s) * DM + c) : 0u; }
        }
        f32x2 acc[16];
#pragma unroll
        for (int t = 0; t < 16; ++t) acc[t] = bias;
#pragma unroll
        for (int j = 0; j < 31; ++j) { const unsigned wp = wl[j * 512 + tid]; const f32x2 w = (f32x2){bf_lo(wp), bf_hi(wp)};
#pragma unroll
            for (int t = 0; t < 16; ++t) acc[t] += w * in[t + j]; }
#pragma unroll
        for (int t = 0; t < 16; ++t) { red[(2 * t) * 512 + tid] = acc[t].x + acc[t].y; red[(2 * t + 1) * 512 + tid] = acc[t].x * acc[t].x + acc[t].y * acc[t].y; }
        __syncthreads();
#pragma unroll
        for (int r = 0; r < 2; ++r) { const int tk = wid * 2 + r; float sm = 0.f, sq = 0.f;
#pragma unroll
            for (int i = 0; i < 8; ++i) { sm += red[(2 * tk) * 512 + lane + 64 * i]; sq += red[(2 * tk + 1) * 512 + lane + 64 * i]; }
            sm = wave_sum(sm); sq = wave_sum(sq);
            if (lane == 0) { const float mean = sm * (1.f / DM), var = sq * (1.f / DM) - mean * mean; stat[2 * tk] = mean; stat[2 * tk + 1] = __builtin_amdgcn_rsqf(var + EPS); } }
        __syncthreads();
#pragma unroll
        for (int t = 0; t < 16; ++t) { const float mean = stat[2 * t], rstd = stat[2 * t + 1];
            const float y0 = (acc[t].x - mean) * rstd * g.x + bb.x, y1 = (acc[t].y - mean) * rstd * g.y + bb.y;
            *(unsigned*)(CA + (size_t)(tok0 + t) * DM + c) = cvt_pk_bf16(y0 * fast_sigmoid(y0), y1 * fast_sigmoid(y1)); }
        __syncthreads();
    }
}

constexpr int SG_WL = 0, SG_GL = 128 * 272, SG_ST = 2 * 128 * 272;
template <bool STORE> __device__ __forceinline__ void sgu_unit(LAS unsigned char* lds, const bf16_t* GEL, const float* STAT, bf16_t* GU, const float* sw, const float* sb, const float* lng, const float* lnb, int unit, const int wave_s) {
    const int tid_ = wave_s * 64 + lane_op();
    const int tid = tid_, lane = tid & 63, wid = wave_s;
    const int chunk = unit >> 3, g = unit & 7, tok0 = chunk * 128, c0 = g * 128;
    LAS float* st = (LAS float*)(lds + SG_ST);
    u32x4 gv4[4];
#pragma unroll
    for (int i = 0; i < 4; ++i) { const int id = tid + 512 * i; gv4[i] = *(const u32x4*)(GEL + (size_t)(tok0 + (id >> 4)) * DM + c0 + (id & 15) * 8); }
    if (tid < 128) { const f32x4* sp = (const f32x4*)(STAT + (size_t)(tok0 + tid) * 32); float s = 0.f, s2 = 0.f;
#pragma unroll
        for (int i = 0; i < 8; ++i) { const f32x4 v = sp[i]; s += v[0] + v[2]; s2 += v[1] + v[3]; }
        const float mean = s * (1.f / DM), var = s2 * (1.f / DM) - mean * mean; st[2 * tid] = mean; st[2 * tid + 1] = __builtin_amdgcn_rsqf(var + EPS); }
#pragma unroll
    for (int i = 0; i < 8; ++i) { const int id = tid + 512 * i, t = id >> 5, s4 = (id & 31) * 4; const f32x4 v = *(const f32x4*)(sw + (size_t)g * 16384 + t * 128 + s4);
        u32x2 w; w.x = cvt_pk_bf16(v[0], v[1]); w.y = cvt_pk_bf16(v[2], v[3]); *(LAS u32x2*)(lds + SG_WL + t * 272 + s4 * 2) = w; }
    __syncthreads();
#pragma unroll
    for (int i = 0; i < 4; ++i) { const int id = tid + 512 * i, s = id >> 4, cc = (id & 15) * 8; const u32x4 v = gv4[i];
        const float mean = st[2 * s], rstd = st[2 * s + 1];
        const f32x4 g0 = *(const f32x4*)(lng + c0 + cc), g1 = *(const f32x4*)(lng + c0 + cc + 4), b0 = *(const f32x4*)(lnb + c0 + cc), b1 = *(const f32x4*)(lnb + c0 + cc + 4);
        float x[8] = {bf_lo(v.x), bf_hi(v.x), bf_lo(v.y), bf_hi(v.y), bf_lo(v.z), bf_hi(v.z), bf_lo(v.w), bf_hi(v.w)};
#pragma unroll
        for (int k = 0; k < 8; ++k) { const float gg = k < 4 ? g0[k & 3] : g1[k & 3], bb = k < 4 ? b0[k & 3] : b1[k & 3]; const float y = (x[k] - mean) * rstd * gg + bb;
            *(LAS bf16_t*)(lds + SG_GL + (cc + k) * 272 + s * 2) = (bf16_t)(cvt_pk_bf16(y, 0.f) & 0xffffu); } }
    __syncthreads();
    const int cb = wid & 3, th = wid >> 2, q = lane & 31, hi = lane >> 5;
    f32x16 d0 = {}, d1 = {};
#pragma unroll
    for (int ks = 0; ks < 8; ++ks) {
        const bf16x8 af = *(const LAS bf16x8*)(lds + SG_GL + (32 * cb + q) * 272 + (16 * ks + 8 * hi) * 2);
        const bf16x8 b0 = *(const LAS bf16x8*)(lds + SG_WL + (64 * th + q) * 272 + (16 * ks + 8 * hi) * 2);
        const bf16x8 b1 = *(const LAS bf16x8*)(lds + SG_WL + (64 * th + 32 + q) * 272 + (16 * ks + 8 * hi) * 2);
        d0 = __builtin_amdgcn_mfma_f32_32x32x16_bf16(af, b0, d0, 0, 0, 0);
        d1 = __builtin_amdgcn_mfma_f32_32x32x16_bf16(af, b1, d1, 0, 0, 0);
    }
#pragma unroll
    for (int tb = 0; tb < 2; ++tb) { const int t = 64 * th + 32 * tb + q; const float bias = sb[g * 128 + t];
        bf16_t* rowp = GU + (size_t)(tok0 + t) * DM + c0 + 32 * cb + 4 * hi;
#pragma unroll
        for (int i = 0; i < 4; ++i) { const u32x2 u = *(const u32x2*)(rowp + 8 * i);
            const float m0 = (tb ? d1[4 * i] : d0[4 * i]) + bias, m1 = (tb ? d1[4 * i + 1] : d0[4 * i + 1]) + bias, m2 = (tb ? d1[4 * i + 2] : d0[4 * i + 2]) + bias, m3 = (tb ? d1[4 * i + 3] : d0[4 * i + 3]) + bias;
            u32x2 w; w.x = cvt_pk_bf16(bf_lo(u.x) * m0, bf_hi(u.x) * m1); w.y = cvt_pk_bf16(bf_lo(u.y) * m2, bf_hi(u.y) * m3);
            if (STORE) *(u32x2*)(rowp + 8 * i) = w; } }
    __syncthreads();
}

constexpr int AT_SLOT = 16384, AT_VOFF = 4 * AT_SLOT;
__device__ __forceinline__ float max3f(float a, float b, float c) { return __builtin_fmaxf(__builtin_fmaxf(a, b), c); }
__device__ __forceinline__ void glds16(const void* gsrc, unsigned lds_dst) { unsigned keep;
    asm volatile("s_mov_b32 %0, m0\n\ts_mov_b32 m0, %2\n\ts_nop 0\n\tglobal_load_lds_dwordx4 %1, off\n\ts_mov_b32 m0, %0" : "=&s"(keep) : "v"(gsrc), "s"(lds_dst) : "memory"); }
template <bool STORE> __device__ __forceinline__ void attn_unit(LAS unsigned char* lds, bf16_t* Q, const bf16_t* Kg, const bf16_t* VT, const float* subg, float lam, float outscale, int unit, const int wave_s) {
    const int tid_ = wave_s * 64 + lane_op();
    const int tid = tid_, lane = tid & 63, wid = wave_s, q = lane & 31, hi = lane >> 5;
    const int bh = unit >> 4, qb = unit & 15, b = bh >> 3, h = bh & 7, map = wid >> 2;
    const int qrow0 = qb * 128 + 32 * (wid & 3);
    const int td = qrow0 >> 6;
    bf16x8 qf[4];
    { const bf16_t* Qp = Q + (size_t)(b * SEQ + qrow0 + q) * DM + h * 128 + map * 64 + 8 * hi;
#pragma unroll
      for (int d0 = 0; d0 < 4; ++d0) qf[d0] = *(const bf16x8*)(Qp + 16 * d0); }
    const float sl = __int_as_float(__builtin_amdgcn_readfirstlane(__float_as_int(exp2f(-(float)(h + 1)) * LOG2E)));
    float sself;
    { const bf16_t* Kp = Kg + (size_t)(b * SEQ + qrow0 + q) * DM + h * 128 + map * 64 + 8 * hi; float a = 0.f;
#pragma unroll
      for (int d0 = 0; d0 < 4; ++d0) { const u32x4 kv = *(const u32x4*)(Kp + 16 * d0); const u32x4 qv = __builtin_bit_cast(u32x4, qf[d0]);
#pragma unroll
          for (int j = 0; j < 4; ++j) a += bf_lo(kv[j]) * bf_lo(qv[j]) + bf_hi(kv[j]) * bf_hi(qv[j]); }
      sself = swap_add(a); }
    const unsigned lds0 = (unsigned)(uintptr_t)lds;
    const bf16_t* kgp; const bf16_t* vgp;
    { const int kr = 8 * wid + (lane >> 4), kc = (lane & 15) ^ (kr & 15); kgp = Kg + (size_t)(b * SEQ + kr) * DM + h * 128 + kc * 8;
      const int vr = 16 * wid + (lane >> 3), vc = (lane & 7) ^ ((vr >> 1) & 7); vgp = VT + (size_t)(h * 128 + vr) * T + b * SEQ + vc * 8; }
    const int kx1 = ((((lane & 15) ^ ((8 * wid + (lane >> 4) + 4) & 15)) - ((lane & 15) ^ ((8 * wid + (lane >> 4)) & 15))) * 8) + 4 * DM;
    const int vx1 = ((((lane & 7) ^ (((16 * wid + (lane >> 3) + 8) >> 1) & 7)) - ((lane & 7) ^ (((16 * wid + (lane >> 3)) >> 1) & 7))) * 8) + 8 * T;
    const unsigned kdst = lds0 + wid * 2048, vdst = lds0 + AT_VOFF + wid * 2048;
#define AT_ISSUE_K(tt) do { const unsigned so_ = (unsigned)(((tt) & 3) * AT_SLOT); const bf16_t* kp_ = kgp + (size_t)(tt) * 64 * DM; \
        glds16(kp_, (unsigned)__builtin_amdgcn_readfirstlane(kdst + so_)); glds16(kp_ + kx1, (unsigned)__builtin_amdgcn_readfirstlane(kdst + so_ + 1024)); } while (0)
#define AT_ISSUE_V(tt) do { const unsigned so_ = (unsigned)(((tt) & 3) * AT_SLOT); const bf16_t* vp_ = vgp + (tt) * 64; \
        glds16(vp_, (unsigned)__builtin_amdgcn_readfirstlane(vdst + so_)); glds16(vp_ + vx1, (unsigned)__builtin_amdgcn_readfirstlane(vdst + so_ + 1024)); } while (0)
#define AT_BAR(N) asm volatile("s_waitcnt vmcnt(" #N ") lgkmcnt(0)\n\ts_barrier" ::: "memory")
    AT_ISSUE_K(0); AT_ISSUE_V(0); AT_ISSUE_K(1); AT_ISSUE_V(1); AT_ISSUE_K(2); AT_ISSUE_V(2); AT_ISSUE_K(3);
    AT_BAR(8);
    f32x16 o[4]; o[0] = f32x16{}; o[1] = f32x16{}; o[2] = f32x16{}; o[3] = f32x16{};
    float mref = sself + 6.0f, lsum = 0.f;
    const int koff = q * 256 + (((map * 8 + hi) ^ (q & 15)) << 4), voff = AT_VOFF + q * 128 + ((hi ^ ((q >> 1) & 7)) << 4);
    const float qposf = (float)(qrow0 + q - 4 * hi);
    f32x16 x0, x1, n0, n1;
#define AT_CINIT(tt, sgn, c0, c1) do { const float ss_ = (sgn) * sl, s2_ = ss_ + ss_, s3_ = s2_ + ss_, s4_ = s2_ + s2_, s8_ = s4_ + s4_, s16_ = s8_ + s8_; float g0_ = ss_ * ((float)(64 * (tt)) - qposf) - mref, g1_ = g0_ + (s16_ + s16_); \
        _Pragma("unroll") for (int g = 0; g < 4; ++g) { c0[4 * g] = g0_; c0[4 * g + 1] = g0_ + ss_; c0[4 * g + 2] = g0_ + s2_; c0[4 * g + 3] = g0_ + s3_; \
            c1[4 * g] = g1_; c1[4 * g + 1] = g1_ + ss_; c1[4 * g + 2] = g1_ + s2_; c1[4 * g + 3] = g1_ + s3_; g0_ += s8_; g1_ += s8_; } } while (0)
#define AT_QK(kslot, c0, c1) do { _Pragma("unroll") for (int d0 = 0; d0 < 4; ++d0) { \
        const bf16x8 k0_ = *(const LAS bf16x8*)(lds + (kslot) + (koff ^ (d0 << 5))); const bf16x8 k1_ = *(const LAS bf16x8*)(lds + (kslot) + (koff ^ (d0 << 5)) + 8192); \
        c0 = __builtin_amdgcn_mfma_f32_32x32x16_bf16(k0_, qf[d0], c0, 0, 0, 0); c1 = __builtin_amdgcn_mfma_f32_32x32x16_bf16(k1_, qf[d0], c1, 0, 0, 0); } } while (0)
#define AT_DIAG(tt, c0, c1) do { const float base_ = qposf - (float)(64 * (tt)); \
        _Pragma("unroll") for (int r = 0; r < 16; ++r) { const float cr_ = (float)((r & 3) + 8 * (r >> 2)); c0[r] -= sl * fabsf(base_ - cr_); c1[r] -= sl * fabsf(base_ - 32.f - cr_); } } while (0)
#define AT_MAX(c0, c1, rm) do { float a_ = fmaxf(c0[0], c1[0]), b_ = fmaxf(c0[1], c1[1]); \
        _Pragma("unroll") for (int r = 2; r < 16; r += 2) { a_ = max3f(a_, c0[r], c1[r]); b_ = max3f(b_, c0[r + 1], c1[r + 1]); } rm = swap_max(fmaxf(a_, b_)); } while (0)
    { const float sg0 = td > 0 ? 1.f : 0.f;
      AT_CINIT(0, sg0, x0, x1); AT_QK(0, x0, x1);
      if (td == 0) AT_DIAG(0, x0, x1);
      float rm; AT_MAX(x0, x1, rm);
      if (__any(rm > 8.0f)) { const float dl = fmaxf(rm, 0.f); mref += dl;
#pragma unroll
          for (int r = 0; r < 16; ++r) { x0[r] -= dl; x1[r] -= dl; } } }
    asm volatile("s_waitcnt lgkmcnt(0)\n\ts_barrier" ::: "memory");
#define AT_SB() __builtin_amdgcn_sched_barrier(0)
#define AT_VRD(dst, kk) do { _Pragma("unroll") for (int d = 0; d < 4; ++d) dst[d] = *(const LAS bf16x8*)(lds + vcur_ + (voff ^ ((kk) << 5)) + d * 4096); } while (0)
#define AT_PV(src, kk) do { const bf16x8 pf_ = __builtin_bit_cast(bf16x8, pw_[kk]); _Pragma("unroll") for (int d = 0; d < 4; ++d) o[d] = __builtin_amdgcn_mfma_f32_32x32x16_bf16(src[d], pf_, o[d], 0, 0, 0); } while (0)
#define AT_BODY(MODE, t, SGN, x0, x1, n0, n1) do { \
        const bool pre_ = ((MODE) != 2) && ((t) + 4 < 32); \
        if (pre_) { AT_ISSUE_K((t) + 4); AT_ISSUE_V((t) + 3); } else if (((MODE) != 2) && ((t) + 3 < 32)) { AT_ISSUE_V((t) + 3); } \
        bf16x8 kf_[4], kg_[4], va_[4], vb_[4]; const int ks_ = (((t) + 1) & 3) * AT_SLOT, vcur_ = ((t) & 3) * AT_SLOT; \
        if ((MODE) != 2) { \
            _Pragma("unroll") for (int d0 = 0; d0 < 2; ++d0) { kf_[2 * d0] = *(const LAS bf16x8*)(lds + ks_ + (koff ^ (d0 << 5))); kf_[2 * d0 + 1] = *(const LAS bf16x8*)(lds + ks_ + (koff ^ (d0 << 5)) + 8192); } \
            AT_CINIT((t) + 1, ((MODE) == 1 ? 0.f : (SGN)), n0, n1); } \
        AT_SB(); \
        if ((MODE) != 2) { \
            _Pragma("unroll") for (int d0 = 0; d0 < 2; ++d0) { kg_[2 * d0] = *(const LAS bf16x8*)(lds + ks_ + (koff ^ ((d0 + 2) << 5))); kg_[2 * d0 + 1] = *(const LAS bf16x8*)(lds + ks_ + (koff ^ ((d0 + 2) << 5)) + 8192); } \
            _Pragma("unroll") for (int d0 = 0; d0 < 2; ++d0) { n0 = __builtin_amdgcn_mfma_f32_32x32x16_bf16(kf_[2 * d0], qf[d0], n0, 0, 0, 0); n1 = __builtin_amdgcn_mfma_f32_32x32x16_bf16(kf_[2 * d0 + 1], qf[d0], n1, 0, 0, 0); } \
            _Pragma("unroll") for (int d0 = 0; d0 < 2; ++d0) { n0 = __builtin_amdgcn_mfma_f32_32x32x16_bf16(kg_[2 * d0], qf[d0 + 2], n0, 0, 0, 0); n1 = __builtin_amdgcn_mfma_f32_32x32x16_bf16(kg_[2 * d0 + 1], qf[d0 + 2], n1, 0, 0, 0); } } \
        AT_VRD(va_, 0); \
        float ps_ = 0.f; u32x4 pw_[4]; \
        _Pragma("unroll") for (int r = 0; r < 16; ++r) { x0[r] = __builtin_amdgcn_exp2f(x0[r]); x1[r] = __builtin_amdgcn_exp2f(x1[r]); ps_ += x0[r] + x1[r]; } \
        lsum += ps_; \
        pw_[0].x = cvt_pk_bf16(x0[0], x0[1]); pw_[0].y = cvt_pk_bf16(x0[2], x0[3]); pw_[0].z = cvt_pk_bf16(x0[4], x0[5]); pw_[0].w = cvt_pk_bf16(x0[6], x0[7]); \
        pw_[1].x = cvt_pk_bf16(x0[8], x0[9]); pw_[1].y = cvt_pk_bf16(x0[10], x0[11]); pw_[1].z = cvt_pk_bf16(x0[12], x0[13]); pw_[1].w = cvt_pk_bf16(x0[14], x0[15]); \
        pw_[2].x = cvt_pk_bf16(x1[0], x1[1]); pw_[2].y = cvt_pk_bf16(x1[2], x1[3]); pw_[2].z = cvt_pk_bf16(x1[4], x1[5]); pw_[2].w = cvt_pk_bf16(x1[6], x1[7]); \
        pw_[3].x = cvt_pk_bf16(x1[8], x1[9]); pw_[3].y = cvt_pk_bf16(x1[10], x1[11]); pw_[3].z = cvt_pk_bf16(x1[12], x1[13]); pw_[3].w = cvt_pk_bf16(x1[14], x1[15]); \
        AT_SB(); \
        AT_VRD(vb_, 1); AT_PV(va_, 0); AT_SB(); \
        AT_VRD(va_, 2); AT_PV(vb_, 1); AT_SB(); \
        float rm_ = 0.f; \
        AT_VRD(vb_, 3); AT_PV(va_, 2); \
        if ((MODE) != 2) { if ((MODE) == 1) AT_DIAG((t) + 1, n0, n1); AT_MAX(n0, n1, rm_); } \
        AT_SB(); \
        AT_PV(vb_, 3); \
        if ((MODE) != 2) { \
            if (__any(rm_ > 8.0f)) { const float dl_ = fmaxf(rm_, 0.f); mref += dl_; const float al_ = __builtin_amdgcn_exp2f(-dl_); lsum *= al_; \
                _Pragma("unroll") for (int r = 0; r < 16; ++r) { n0[r] -= dl_; n1[r] -= dl_; } \
                _Pragma("unroll") for (int d = 0; d < 4; ++d) _Pragma("unroll") for (int r = 0; r < 16; ++r) o[d][r] *= al_; } \
            } \
        if (pre_) AT_BAR(8); else AT_BAR(0); } while (0)
    {
        int t = 0;
        for (; t + 2 < td; t += 2) { AT_BODY(0, t, 1.0f, x0, x1, n0, n1); AT_BODY(0, t + 1, 1.0f, n0, n1, x0, x1); }
        if (t + 1 < td) { AT_BODY(0, t, 1.0f, x0, x1, n0, n1); x0 = n0; x1 = n1; ++t; }
        if (td >= 1) { AT_BODY(1, t, 0.0f, x0, x1, n0, n1); x0 = n0; x1 = n1; ++t; }
        for (; t + 1 < 31; t += 2) { AT_BODY(0, t, -1.0f, x0, x1, n0, n1); AT_BODY(0, t + 1, -1.0f, n0, n1, x0, x1); }
        if (t < 31) { AT_BODY(0, t, -1.0f, x0, x1, n0, n1); x0 = n0; x1 = n1; ++t; }
        AT_BODY(2, 31, 0.0f, x0, x1, n0, n1);
    }
#undef AT_BODY
#undef AT_ISSUE_K
#undef AT_ISSUE_V
#undef AT_BAR
#undef AT_SB
#undef AT_VRD
#undef AT_PV
#undef AT_CINIT
#undef AT_QK
#undef AT_DIAG
#undef AT_MAX
    const float inv = 1.0f / swap_add(lsum);
    LAS float* xb = (LAS float*)lds + (wid & 3) * 4096;
    if (map == 1) {
#pragma unroll
        for (int d = 0; d < 4; ++d)
#pragma unroll
            for (int r = 0; r < 16; ++r) xb[(d * 16 + r) * 64 + lane] = o[d][r] * inv;
    }
    __syncthreads();
    if (STORE && map == 0) {
        float ss = 0.f;
#pragma unroll
        for (int d = 0; d < 4; ++d)
#pragma unroll
            for (int r = 0; r < 16; ++r) { const float v = o[d][r] * inv - lam * xb[(d * 16 + r) * 64 + lane]; o[d][r] = v; ss += v * v; }
        ss = swap_add(ss);
        const float rstd = outscale / sqrtf(ss * (1.f / 128.f) + EPS);
        const int l2 = lane_op();
        bf16_t* orow = Q + (size_t)(b * SEQ + qrow0 + (l2 & 31)) * DM + h * 128 + 4 * (l2 >> 5);
#pragma unroll
        for (int d = 0; d < 4; ++d)
#pragma unroll
            for (int i = 0; i < 4; ++i) { const f32x4 gg = *(const f32x4*)(subg + 32 * d + 8 * i + 4 * (l2 >> 5));
                u32x2 w; w.x = cvt_pk_bf16(o[d][4 * i] * rstd * gg[0], o[d][4 * i + 1] * rstd * gg[1]); w.y = cvt_pk_bf16(o[d][4 * i + 2] * rstd * gg[2], o[d][4 * i + 3] * rstd * gg[3]);
                *(u32x2*)(orow + 32 * d + 8 * i) = w; }
    }
    __syncthreads();
}


#define XB_TMO      128
#define XB_XCNT(j)  (256  + 64 * (j))
#define XB_XSUB(j)  (1280 + 64 * (j))
#define XB_XGEN(j)  (2304 + 64 * (j))
#define XB_TOP      3328
#define XB_TOPGEN   3392
#define XCD_BAR_WORDS 3456
#define XB_SPIN_CAP (1u << 22)
__device__ __forceinline__ unsigned xb_ld(unsigned* p)              { return __hip_atomic_load(p, __ATOMIC_RELAXED, __HIP_MEMORY_SCOPE_AGENT); }
__device__ __forceinline__ unsigned xb_add(unsigned* p, unsigned v) { return __hip_atomic_fetch_add(p, v, __ATOMIC_RELAXED, __HIP_MEMORY_SCOPE_AGENT); }
__device__ __forceinline__ unsigned xb_xcc_id() { return (unsigned)__builtin_amdgcn_s_getreg((3 << 11) | 20) & 0xFu; }
#define XB_SPIN(cond, bar) do { unsigned _sp = 0; while (cond) { __builtin_amdgcn_s_sleep(1); \
    if ((++_sp & 255u) == 0u) { if (xb_ld(&(bar)[XB_TMO])) break; if (_sp > XB_SPIN_CAP) { atomicAdd(&(bar)[XB_TMO], 1u); break; } } } } while (0)
struct XcdBarrier { unsigned* bar; unsigned x; volatile LAS unsigned* st; };
__device__ __forceinline__ XcdBarrier xcd_barrier_post(unsigned* bar, volatile LAS unsigned* st, bool t0) {
    XcdBarrier b; b.bar = bar; b.x = xb_xcc_id(); b.st = st;
    if (t0) (void)xb_add(&bar[XB_XCNT(b.x)], 1u);
    return b;
}
__device__ __forceinline__ void xcd_barrier_complete(unsigned* bar, unsigned x, unsigned& nloc, unsigned& nx) {
    const unsigned G = gridDim.x * gridDim.y * gridDim.z;
    unsigned sum, cnt, mine, sp = 0u;
    for (;;) {
        sum = 0u; cnt = 0u; mine = 0u;
#pragma unroll
        for (unsigned j = 0; j < 16; ++j) { const unsigned c = xb_ld(&bar[XB_XCNT(j)]); sum += c; cnt += (c > 0u) ? 1u : 0u; mine = (j == x) ? c : mine; }
        if (sum == G) break;
        __builtin_amdgcn_s_sleep(1);
        if ((++sp & 255u) == 0u) { if (xb_ld(&bar[XB_TMO])) break; if (sp > XB_SPIN_CAP) { atomicAdd(&bar[XB_TMO], 1u); break; } }
    }
    nloc = mine > 0u ? mine : 1u; nx = cnt > 0u ? cnt : 1u;
}
__device__ __forceinline__ void xcd_barrier(const XcdBarrier& b, bool t0) {
    asm volatile("s_waitcnt vmcnt(0)" ::: "memory");
    __syncthreads();
    if (t0) {
        unsigned* bar = b.bar;
        __builtin_amdgcn_s_waitcnt(0);
        unsigned nloc = b.st[0], nx = b.st[1];
        if (nloc == 0u) { xcd_barrier_complete(bar, b.x, nloc, nx); b.st[0] = nloc; b.st[1] = nx; }
        const unsigned old = xb_add(&bar[XB_XSUB(b.x)], 1u);
        const unsigned gen = old / nloc;
        if (old + 1u == (gen + 1u) * nloc) {
            __builtin_amdgcn_fence(__ATOMIC_RELEASE, "agent");
            asm volatile("s_waitcnt vmcnt(0)" ::: "memory");
            const unsigned og = xb_add(&bar[XB_TOP], 1u);
            const unsigned tg = og / nx;
            if (og + 1u == (tg + 1u) * nx) xb_add(&bar[XB_TOPGEN], 1u);
            else XB_SPIN(xb_ld(&bar[XB_TOPGEN]) == tg, bar);
            __builtin_amdgcn_fence(__ATOMIC_ACQUIRE, "agent");
            xb_add(&bar[XB_XGEN(b.x)], 1u);
            asm volatile("s_waitcnt vmcnt(0)" ::: "memory");
        } else {
            XB_SPIN(xb_ld(&bar[XB_XGEN(b.x)]) == gen, bar);
            __builtin_amdgcn_fence(__ATOMIC_ACQUIRE, "agent");
            asm volatile("s_waitcnt vmcnt(0)" ::: "memory");
        }
    }
    __syncthreads();
}

constexpr int LDS_BYTES = 147456;
#ifndef PROBE_GEMM2
#define PROBE_GEMM2 0
#endif
#ifndef FUSE_NORM
#define FUSE_NORM 1
#endif
#if PROBE_GEMM2
constexpr unsigned long long SEQ_PACK = 0x7665543322100ull; constexpr int NPL = 13;
#elif FUSE_NORM
constexpr unsigned long long SEQ_PACK = 0x7653210ull; constexpr int NPL = 7;
#else
constexpr unsigned long long SEQ_PACK = 0x76543210ull; constexpr int NPL = 8;
#endif
constexpr int N_PHASES = 1 + NPL * DEPTH;
#ifndef PROBE_GEMM2
#define PROBE_GEMM2 0
#endif
#ifndef PROBE_SYNC
#define PROBE_SYNC 0
#endif
#ifndef PROBE_CONV2
#define PROBE_CONV2 0
#endif
#ifndef PROBE_P02
#define PROBE_P02 0
#endif
#ifndef PROBE_SGU2
#define PROBE_SGU2 0
#endif
#ifndef PROBE_ATT2
#define PROBE_ATT2 0
#endif
#ifndef PHMASK
#define PHMASK 0xfff
#endif

typedef const __attribute__((address_space(4))) Args* CArgs;
#define PH_ON(bit) if constexpr ((PHMASK & (bit)) != 0)
__global__ void __launch_bounds__(NTHREADS, 2) fwd_megakernel(Args a_unused) {
    extern __shared__ __attribute__((aligned(16))) unsigned char lds_raw[];
    LAS unsigned char* lds = (LAS unsigned char*)lds_raw;
    CArgs ap0 = (CArgs)__builtin_amdgcn_kernarg_segment_ptr();
    const int lo = ap0->lo, hi = ap0->hi;
    const int wave = __builtin_amdgcn_readfirstlane((int)threadIdx.x >> 6);
    const bool t0 = (threadIdx.x == 0);
    volatile LAS unsigned* bst = (volatile LAS unsigned*)(lds + 131072 + 1024);
    if (t0) { bst[0] = 0u; bst[1] = 0u; }
    __syncthreads();
    const XcdBarrier gbar = xcd_barrier_post((unsigned*)ap0->ws, bst, t0);
    for (int ph = lo; ph < hi; ++ph) {
        CArgs ap = ap0; asm volatile("" : "+s"(ap));
        const int G = gridDim.x, bx = blockIdx.x;
        const int vcu = (G % 8 == 0) ? (bx % 8) * (G / 8) + bx / 8 : bx;
        const int gw = vcu * NWAVES + wave, NGW = G * NWAVES;
        unsigned char* ws = ap->ws;
        bf16_t* W = (bf16_t*)(ws + WS_W);
        bf16_t* XN = (bf16_t*)(ws + WS_XN);
        if (ph == 0) { PH_ON(256) { for (int rep_ = 0; rep_ < 1 + PROBE_P02; ++rep_) {
            const int lane = lane_op();
            convert_weights(ap, 0, lds, gw, NGW, wave, lane);
            const float* x = ap->in[I_X]; const float* g = ap->in[I_NMPRE];
            for (int m = gw; m < T; m += 4 * NGW) rms_rows4_to_bf16(x + (size_t)m * DM, (size_t)NGW * DM, g, XN + (size_t)m * DM, lane);
            __syncthreads(); } }
        } else {
            const int l = (ph - 1) / NPL, k = (int)((SEQ_PACK >> (4 * ((ph - 1) % NPL))) & 15ull);
            if (k == 0) { PH_ON(1) {
                SchedIn S{XN, W + WO_IN, G, bx};
                EpiIn E{(bf16_t*)(ws + WS_AG), (bf16_t*)(ws + WS_Q), (bf16_t*)(ws + WS_K), (bf16_t*)(ws + WS_GU), (bf16_t*)(ws + WS_GEL), (bf16_t*)(ws + WS_VT), (float*)(ws + WS_STAT)};
                pg8::gemm_phase<EpiIn, SchedIn>(lds, wave, DM, S, E); }
            } else if (k == 1) { PH_ON(2) {
                const int per = (1024 + G - 1) / G;
                PH_ON(512) {
                    const int lane = lane_op();
                    const float la = wave_sum(ap->in[I_LQ1][l * 64 + lane] * ap->in[I_LK1][l * 64 + lane]), lb = wave_sum(ap->in[I_LQ2][l * 64 + lane] * ap->in[I_LK2][l * 64 + lane]);
                    const float lam_init = 0.8f - 0.6f * expf(-0.3f * (float)l);
                    const float lam = __int_as_float(__builtin_amdgcn_readfirstlane(__float_as_int(expf(la) - expf(lb) + lam_init)));
                    const float oscale = __int_as_float(__builtin_amdgcn_readfirstlane(__float_as_int(1.0f - lam_init)));
                    const float* subg = ap->in[I_SUBG] + l * 128;
                    if constexpr (PROBE_ATT2 != 0) { for (int i = 0; i < per; ++i) { const int u = vcu * per + i; if (u < 1024) attn_unit<false>(lds, (bf16_t*)(ws + WS_Q), (const bf16_t*)(ws + WS_K), (const bf16_t*)(ws + WS_VT), subg, lam, oscale, u, wave); } }
                    for (int i = 0; i < per; ++i) { int u = vcu * per + i;
                        if (G == 256) { const int bb = vcu >> 5, w = vcu & 31; u = ((bb * 8 + 2 * i + (w >> 4)) << 4) | (w & 15); }
                        if (u < 1024) attn_unit<true>(lds, (bf16_t*)(ws + WS_Q), (const bf16_t*)(ws + WS_K), (const bf16_t*)(ws + WS_VT), subg, lam, oscale, u, wave); }
                }
                PH_ON(1024) {
                    const float* cw = ap->in[I_CONVW] + (size_t)l * 31 * DM; const float* cb = ap->in[I_CONVB] + l * DM; const float* lg = ap->in[I_CLNG] + l * DM; const float* lb2 = ap->in[I_CLNB] + l * DM;
                    for (int rep_ = 0; rep_ < 1 + PROBE_CONV2; ++rep_) { const int u0 = vcu * per; int nun = 1024 - u0; nun = nun < 0 ? 0 : (nun > per ? per : nun);
                        if ((128 % per) == 0) conv_run(lds, (const bf16_t*)(ws + WS_AG), (bf16_t*)(ws + WS_CA), cw, cb, lg, lb2, u0, nun, wave);
                        else for (int i = 0; i < nun; ++i) conv_run(lds, (const bf16_t*)(ws + WS_AG), (bf16_t*)(ws + WS_CA), cw, cb, lg, lb2, u0 + i, 1, wave); }
                }
                PH_ON(2048) {
                    const float* sw = ap->in[I_SGUW] + (size_t)l * 8 * 16384; const float* sb = ap->in[I_SGUB] + l * 1024; const float* lg = ap->in[I_SLNG] + l * DM; const float* lb2 = ap->in[I_SLNB] + l * DM;
                    if constexpr (PROBE_SGU2 != 0) { for (int i = 0; i < per; ++i) { const int u = vcu * per + i; if (u < 1024) sgu_unit<false>(lds, (const bf16_t*)(ws + WS_GEL), (const float*)(ws + WS_STAT), (bf16_t*)(ws + WS_GU), sw, sb, lg, lb2, u, wave); } }
                    for (int i = 0; i < per; ++i) { const int u = vcu * per + i; if (u < 1024) sgu_unit<true>(lds, (const bf16_t*)(ws + WS_GEL), (const float*)(ws + WS_STAT), (bf16_t*)(ws + WS_GU), sw, sb, lg, lb2, u, wave); }
                } }
            } else if (k == 2) { PH_ON(4) {
                SchedProj S{ws, G, bx};
                EpiProj E{(bf16_t*)(ws + WS_GS), (float*)(ws + WS_SB), (bf16_t*)(ws + WS_MIXPRE), ap->in[I_BGATE] + l * 3072};
                pg8::gemm_phase<EpiProj, SchedProj>(lds, wave, DM, S, E); }
            } else if (k == 3) { PH_ON(8) {
                SchedSimple S{(const bf16_t*)(ws + WS_MIXPRE), W + WO_OUT, 64, 4, DM, G, bx};
#if FUSE_NORM
                float* out = ap->out;
                EpiNormRes E{(l == 0) ? ap->in[I_X] : out, out, ap->in[I_NMPOST] + l * DM, ap->in[I_NFPRE] + l * DM, XN, (float*)(ws + WS_XBUF) + (size_t)(l * 2 + 0) * 2 * T * 4, (unsigned*)(ws + WS_CNT) + (l * 2 + 0) * 2 * 64 * 64, lds};
                pg8::gemm_phase<EpiNormRes, SchedSimple>(lds, wave, DM, S, E);
#else
                EpiF32 E{(float*)(ws + WS_MIX), DM};
                pg8::gemm_phase<EpiF32, SchedSimple>(lds, wave, DM, S, E);
#endif
                }
            } else if (k == 4) { PH_ON(16) {
                const int lane = lane_op();
                float* out = ap->out; const float* xin = (l == 0) ? ap->in[I_X] : out; const float* MIX = (const float*)(ws + WS_MIX);
                const float* gp = ap->in[I_NMPOST] + l * DM; const float* gn = ap->in[I_NFPRE] + l * DM;
                for (int m = gw; m < T; m += NGW) resid_norm_row(MIX + (size_t)m * DM, xin + (size_t)m * DM, out + (size_t)m * DM, gp, gn, XN + (size_t)m * DM, lane); }
            } else if (k == 5) { PH_ON(32) {
                SchedSimple S{XN, W + WO_UP, 64, 16, DM, G, bx};
                EpiRelu2 E{(bf16_t*)(ws + WS_H), DFF};
                pg8::gemm_phase<EpiRelu2, SchedSimple>(lds, wave, DM, S, E); }
            } else if (k == 6) { PH_ON(64) {
                SchedSimple S{(const bf16_t*)(ws + WS_H), W + WO_DOWN, 64, 4, DFF, G, bx};
#if FUSE_NORM
                float* out = ap->out;
                EpiNormRes E{out, out, ap->in[I_NFPOST] + l * DM, (l + 1 < DEPTH) ? ap->in[I_NMPRE] + (l + 1) * DM : nullptr, XN, (float*)(ws + WS_XBUF) + (size_t)(l * 2 + 1) * 2 * T * 4, (unsigned*)(ws + WS_CNT) + (l * 2 + 1) * 2 * 64 * 64, lds};
                pg8::gemm_phase<EpiNormRes, SchedSimple>(lds, wave, DFF, S, E);
#else
                EpiF32 E{(float*)(ws + WS_MIX), DM};
                pg8::gemm_phase<EpiF32, SchedSimple>(lds, wave, DFF, S, E);
#endif
                }
            } else { PH_ON(128) {
                const int lane = lane_op();
                float* out = ap->out; const float* MIX = (const float*)(ws + WS_MIX);
                const float* gp = ap->in[I_NFPOST] + l * DM; const float* gnext = (l + 1 < DEPTH) ? ap->in[I_NMPRE] + (l + 1) * DM : nullptr;
#if !FUSE_NORM
                for (int m = gw; m < T; m += NGW) resid_norm_row(MIX + (size_t)m * DM, out + (size_t)m * DM, out + (size_t)m * DM, gp, gnext, XN + (size_t)m * DM, lane);
#endif
                if (l + 1 < DEPTH) { convert_weights(ap, l + 1, lds, gw, NGW, wave, lane); __syncthreads(); } }
            }
        }
        if (ph + 1 < hi) { if (hi > 4096) cg::this_grid().sync();
            xcd_barrier(gbar, t0); if constexpr (PROBE_SYNC != 0) xcd_barrier(gbar, t0); }
    }
}

extern "C" void kernel_launch(void* const* d_in, const int* in_sizes, int n_in, void* d_out, int out_size, void* d_ws, size_t ws_size, hipStream_t stream) {
    static int grid = 0;
    if (grid == 0) {
        if (n_in != 26 || in_sizes[0] != T * DM || out_size != T * DM || ws_size < WS_END) {
            fprintf(stderr, "kernel_launch: unexpected problem: n_in %d in0 %d out %d ws %zu (need %zu)\n", n_in, n_in > 0 ? in_sizes[0] : -1, out_size, ws_size, (size_t)WS_END); grid = -1; return; }
        int dev = 0, cus = 0, per_cu = 0;
        hipGetDevice(&dev); hipDeviceGetAttribute(&cus, hipDeviceAttributeMultiprocessorCount, dev);
        if (hipFuncSetAttribute((const void*)fwd_megakernel, hipFuncAttributeMaxDynamicSharedMemorySize, LDS_BYTES) != hipSuccess) { fprintf(stderr, "kernel_launch: hipFuncSetAttribute failed\n"); grid = -1; return; }
        if (hipOccupancyMaxActiveBlocksPerMultiprocessor(&per_cu, (const void*)fwd_megakernel, NTHREADS, LDS_BYTES) != hipSuccess || per_cu < 1) { fprintf(stderr, "kernel_launch: occupancy query says %d\n", per_cu); per_cu = 1; }
        (void)hipGetLastError();
        grid = cus * 1;
        if (FUSE_NORM && grid != 256) { fprintf(stderr, "kernel_launch: the fused norm epilogues need a 256-workgroup grid, got %d\n", grid); grid = -1; return; }
        fprintf(stderr, "kernel_launch: grid %d (cus %d, per_cu %d)\n", grid, cus, per_cu);
    }
    if (grid < 0) return;
    if (hipMemsetAsync(d_ws, 0, CTL_BYTES, stream) != hipSuccess) { fprintf(stderr, "kernel_launch: memset failed\n"); return; }
    Args a{};
    for (int i = 0; i < 26; ++i) a.in[i] = (const float*)d_in[i];
    a.out = (float*)d_out; a.ws = (unsigned char*)d_ws;
#if MK_N_LAUNCHES == 1
    a.lo = 0; a.hi = N_PHASES;
    void* args[] = {&a};
    hipError_t e = hipLaunchCooperativeKernel((const void*)fwd_megakernel, dim3(grid), dim3(NTHREADS), args, LDS_BYTES, stream);
    if (e != hipSuccess) fprintf(stderr, "cooperative launch failed: %s (grid %d)\n", hipGetErrorString(e), grid);
#else
    for (int ph = 0; ph < N_PHASES; ++ph) { a.lo = ph; a.hi = ph + 1; hipLaunchKernelGGL(fwd_megakernel, dim3(grid), dim3(NTHREADS), LDS_BYTES, stream, a); }
#endif
}
```
